# Optimizing an MI355X kernel written in HIP

```python
import jax, jax.numpy as jnp
from jax import lax
import numpy as np

D_MODEL = 1024
BATCH = 2
SEQ = 16384
DEPTH = 4

HEAD_DIM = 64
N_TOK_HEADS = 12
N_KV_HEADS = 3
GQA_GROUP = N_TOK_HEADS // N_KV_HEADS
N_MEM_HEADS = 4
N_MEM = 256
Q_W = N_TOK_HEADS * HEAD_DIM
KV_W = N_KV_HEADS * HEAD_DIM
QM_W = N_MEM_HEADS * HEAD_DIM
IN_W = Q_W + 2 * KV_W + QM_W
MIX_WIDTH = Q_W + QM_W
D_FF = -(-8 * D_MODEL // (3 * 256)) * 256
N_MIXERS = 3
BLOCK = 128
A_RADIUS = 128
C_GROUPS = ((128, 1), (512, 4), (2048, 16))
ROPE_THETA = 500000.0
ROPE_DIMS = HEAD_DIM // 4
AXIAL_THETA = 10000.0
GRID_W = 64
EPS = 1e-6
N_A = (DEPTH + 2) // N_MIXERS
N_B = (DEPTH + 1) // N_MIXERS
ATTN_SCALE = HEAD_DIM ** -0.5

kernel_name = 'hybrid_interleaved_window_axial_dilated_encoder'


def rms_norm(x, g):
    xf = x.astype(jnp.float32)
    y = xf * lax.rsqrt(jnp.mean(xf * xf, axis=-1, keepdims=True) + EPS)
    return (y * g.astype(jnp.float32)).astype(x.dtype)


def rope_table(pos, n_dims, theta):
    inv = theta ** (-(jnp.arange(0, n_dims, 2, dtype=jnp.float32) / n_dims))
    ang = pos.astype(jnp.float32)[:, None] * inv[None, :]
    return jnp.cos(ang), jnp.sin(ang)


def apply_rotary(x, cos, sin):
    half = x.shape[-1] // 2
    xf = x.astype(jnp.float32)
    x1, x2 = xf[..., :half], xf[..., half:]
    c, s = cos[:, None, :], sin[:, None, :]
    return jnp.concatenate([x1 * c - x2 * s, x2 * c + x1 * s], axis=-1).astype(x.dtype)


def partial_rope(x, cos, sin):
    return jnp.concatenate([apply_rotary(x[..., :ROPE_DIMS], cos, sin), x[..., ROPE_DIMS:]], axis=-1)


def axial_rope(x, cos_r, sin_r, cos_c, sin_c):
    half = HEAD_DIM // 2
    return jnp.concatenate([apply_rotary(x[..., :half], cos_r, sin_r),
                            apply_rotary(x[..., half:], cos_c, sin_c)], axis=-1)


def banded_attention(q, k, v, radius, sink=None):
    B, L, KVH, G, HD = q.shape
    blk = radius
    nb = -(-L // blk)
    Lp = nb * blk
    pad = Lp - L
    qb = jnp.pad(q, [(0, 0), (0, pad), (0, 0), (0, 0), (0, 0)]).reshape(B, nb, blk, KVH, G, HD)

    def windows(t):
        tp = jnp.pad(t, [(0, 0), (blk, blk + pad), (0, 0), (0, 0)]).reshape(B, nb + 2, blk, KVH, HD)
        return jnp.concatenate([tp[:, :-2], tp[:, 1:-1], tp[:, 2:]], axis=2)

    kw, vw = windows(k), windows(v)
    qpos = jnp.arange(Lp).reshape(nb, blk)
    kpos = (jnp.arange(nb)[:, None] - 1) * blk + jnp.arange(3 * blk)[None, :]
    mask = ((jnp.abs(qpos[:, :, None] - kpos[:, None, :]) <= radius)
            & (kpos >= 0)[:, None, :] & (kpos < L)[:, None, :])
    s = jnp.einsum('bnqhgd,bnkhd->bnhgqk', qb, kw, preferred_element_type=jnp.float32) * ATTN_SCALE
    s = jnp.where(mask[None, :, None, None], s, -jnp.inf)
    m = jnp.max(s, axis=-1, keepdims=True)
    if sink is not None:
        sk = sink.astype(jnp.float32)[None, None, :, :, None, None]
        m = jnp.maximum(m, sk)
    p = jnp.exp(s - m)
    denom = jnp.sum(p, axis=-1)
    if sink is not None:
        denom = denom + jnp.exp(sk - m)[..., 0]
    o = jnp.einsum('bnhgqk,bnkhd->bnqhgd', p.astype(v.dtype), vw)
    den_t = jnp.transpose(denom, (0, 1, 4, 2, 3))
    o = (o / den_t[..., None]).astype(q.dtype).reshape(B, Lp, KVH, G, HD)[:, :L]
    lse = jnp.transpose(m[..., 0] + jnp.log(denom), (0, 1, 4, 2, 3)).reshape(B, Lp, KVH, G)[:, :L]
    return o, lse


def full_attention_blocks(q, k, v):
    B, S, KVH, G, HD = q.shape
    nb = S // BLOCK
    qb = jnp.moveaxis(q.reshape(B, nb, BLOCK, KVH, G, HD), 1, 0)

    def one_block(qblk):
        s = jnp.einsum('bqhgd,bkhd->bhgqk', qblk, k, preferred_element_type=jnp.float32) * ATTN_SCALE
        p = jax.nn.softmax(s, axis=-1)
        return jnp.einsum('bhgqk,bkhd->bqhgd', p.astype(v.dtype), v)

    o = lax.map(one_block, qb)
    return jnp.moveaxis(o, 0, 1).reshape(B, S, KVH, G, HD)


def mixer_a(q, k, v, sink, cos_p, sin_p):
    B, S = q.shape[:2]
    q = partial_rope(q, cos_p, sin_p).reshape(B, S, N_KV_HEADS, GQA_GROUP, HEAD_DIM)
    k = partial_rope(k, cos_p, sin_p)
    o, _ = banded_attention(q, k, v, A_RADIUS, sink.reshape(N_KV_HEADS, GQA_GROUP))
    return o.reshape(B, S, Q_W)


def mixer_b(q, k, v, qk_g, cos_r, sin_r, cos_c, sin_c):
    B, S = q.shape[:2]
    q = axial_rope(rms_norm(q, qk_g[0]), cos_r, sin_r, cos_c, sin_c)
    k = axial_rope(rms_norm(k, qk_g[1]), cos_r, sin_r, cos_c, sin_c)
    o = full_attention_blocks(q.reshape(B, S, N_KV_HEADS, GQA_GROUP, HEAD_DIM), k, v)
    return o.reshape(B, S, Q_W)


def dilated_group(q, k, v, dil, radius):
    B, S = q.shape[:2]
    L = S // dil

    def split(t):
        t = jnp.moveaxis(t.reshape((B, L, dil) + t.shape[2:]), 2, 1)
        return t.reshape((B * dil, L) + t.shape[3:])

    def merge(t):
        t = jnp.moveaxis(t.reshape((B, dil, L) + t.shape[2:]), 1, 2)
        return t.reshape((B, S) + t.shape[3:])

    o, lse = banded_attention(split(q)[:, :, None], split(k)[:, :, None], split(v)[:, :, None], radius)
    return merge(o[:, :, 0]), merge(lse[:, :, 0])


def mixer_c(q, k, v, cos_p, sin_p):
    B, S = q.shape[:2]
    q = partial_rope(q, cos_p, sin_p)
    k = partial_rope(k, cos_p, sin_p)
    outs, lses = [], []
    for g, (window, dil) in enumerate(C_GROUPS):
        o, l = dilated_group(q[:, :, g * GQA_GROUP:(g + 1) * GQA_GROUP], k[:, :, g], v[:, :, g],
                             dil, window // (2 * dil))
        outs.append(o)
        lses.append(l)
    alpha = jax.nn.softmax(jnp.stack(lses, axis=2), axis=2)
    o = jnp.stack(outs, axis=2) * alpha[..., None].astype(q.dtype)
    return o.reshape(B, S, Q_W)


def memory_attention(qm, km, vm):
    s = jnp.einsum('bshd,bmhd->bhsm', qm, km, preferred_element_type=jnp.float32) * ATTN_SCALE
    p = jax.nn.softmax(s, axis=-1)
    o = jnp.einsum('bhsm,bmhd->bshd', p.astype(vm.dtype), vm)
    return o.reshape(qm.shape[0], qm.shape[1], QM_W)


def setup_inputs(seed: int = 0) -> dict:
    key = jax.random.key(seed)
    ks = jax.random.split(key, 14)
    nrm = jax.random.normal
    f32 = jnp.float32
    return {
        'x': nrm(ks[0], (BATCH, SEQ, D_MODEL), f32),
        'mem': nrm(ks[1], (BATCH, N_MEM, D_MODEL), f32),
        'mem_norm_g': 1.0 + 0.02 * nrm(ks[2], (D_MODEL,), f32),
        'w_in': nrm(ks[3], (DEPTH, D_MODEL, IN_W), f32) * D_MODEL ** -0.5,
        'w_mem_kv': nrm(ks[4], (DEPTH, D_MODEL, 2 * QM_W), f32) * D_MODEL ** -0.5,
        'w_o': nrm(ks[5], (DEPTH, MIX_WIDTH, D_MODEL), f32) * MIX_WIDTH ** -0.5,
        'g_mix_pre': 1.0 + 0.02 * nrm(ks[6], (DEPTH, D_MODEL), f32),
        'g_mix_post': 1.0 + 0.02 * nrm(ks[7], (DEPTH, D_MODEL), f32),
        'attn_sink': 0.5 * nrm(ks[8], (N_A, N_TOK_HEADS), f32),
        'qk_norm_g': 1.0 + 0.02 * nrm(ks[9], (N_B, 2, HEAD_DIM), f32),
        'w_gate_up': nrm(ks[10], (DEPTH, D_MODEL, 2 * D_FF), f32) * D_MODEL ** -0.5,
        'w_down': nrm(ks[11], (DEPTH, D_FF, D_MODEL), f32) * D_FF ** -0.5,
        'g_ffn_pre': 1.0 + 0.02 * nrm(ks[12], (DEPTH, D_MODEL), f32),
        'g_ffn_post': 1.0 + 0.02 * nrm(ks[13], (DEPTH, D_MODEL), f32),
    }


def reference(x, mem, mem_norm_g, w_in, w_mem_kv, w_o, g_mix_pre, g_mix_post, attn_sink,
              qk_norm_g, w_gate_up, w_down, g_ffn_pre, g_ffn_post):
    B, S, _ = x.shape
    rows = S // GRID_W
    pos = jnp.arange(S, dtype=jnp.int32)
    row_ids = jnp.repeat(jnp.arange(rows, dtype=jnp.int32), GRID_W)
    col_ids = jnp.tile(jnp.arange(GRID_W, dtype=jnp.int32), rows)
    cos_p, sin_p = rope_table(pos, ROPE_DIMS, ROPE_THETA)
    cos_r, sin_r = rope_table(row_ids, HEAD_DIM // 2, AXIAL_THETA)
    cos_c, sin_c = rope_table(col_ids, HEAD_DIM // 2, AXIAL_THETA)
    mem_n = rms_norm(mem, mem_norm_g)

    for i in range(DEPTH):
        h = rms_norm(x, g_mix_pre[i])
        proj = h @ w_in[i]
        q = proj[..., :Q_W].reshape(B, S, N_TOK_HEADS, HEAD_DIM)
        k = proj[..., Q_W:Q_W + KV_W].reshape(B, S, N_KV_HEADS, HEAD_DIM)
        v = proj[..., Q_W + KV_W:Q_W + 2 * KV_W].reshape(B, S, N_KV_HEADS, HEAD_DIM)
        qm = proj[..., Q_W + 2 * KV_W:].reshape(B, S, N_MEM_HEADS, HEAD_DIM)
        kind = i % N_MIXERS
        if kind == 0:
            tok = mixer_a(q, k, v, attn_sink[i // N_MIXERS], cos_p, sin_p)
        elif kind == 1:
            tok = mixer_b(q, k, v, qk_norm_g[i // N_MIXERS], cos_r, sin_r, cos_c, sin_c)
        else:
            tok = mixer_c(q, k, v, cos_p, sin_p)
        mkv = mem_n @ w_mem_kv[i]
        km = mkv[..., :QM_W].reshape(B, N_MEM, N_MEM_HEADS, HEAD_DIM)
        vm = mkv[..., QM_W:].reshape(B, N_MEM, N_MEM_HEADS, HEAD_DIM)
        mo = memory_attention(qm, km, vm)
        o = jnp.concatenate([tok, mo], axis=-1) @ w_o[i]
        x = x + rms_norm(o, g_mix_post[i])

        h = rms_norm(x, g_ffn_pre[i])
        gu = h @ w_gate_up[i]
        f = (jax.nn.silu(gu[..., :D_FF]) * gu[..., D_FF:]) @ w_down[i]
        x = x + rms_norm(f, g_ffn_post[i])
    return x
```

```cpp
#include <hip/hip_runtime.h>
#include <hip/hip_cooperative_groups.h>
#include <cstdio>
#include <cstdint>
#include <cmath>
namespace cg = cooperative_groups;
namespace pg8 {
#define PG8_LAS __attribute__((address_space(3)))
typedef unsigned short bf16_t;
typedef short bf16x8 __attribute__((ext_vector_type(8)));
typedef float f32x4 __attribute__((ext_vector_type(4)));
typedef unsigned u32x4 __attribute__((ext_vector_type(4)));
constexpr int BM = 256, BK = 64, HALF = 128, HTB = HALF * BK * 2  , STAGE_BYTES = 8 * HTB, NXCD = 8, WGM = 8;

__host__ __device__ __forceinline__ int lds_byte(int r, int c) { const int st = (r >> 4) * 2 + (c >> 5), rr = r & 15, cc = c & 31, ob = rr * 64 + cc * 2; return st * 1024 + (ob ^ (((ob >> 9) & 1) << 5)); }
__host__ __device__ __forceinline__ void stage_rc(int b, int& R, int& C) { const int st = b / 1024, sb = b % 1024, swz = sb ^ (((sb >> 9) & 1) << 5); R = (st >> 1) * 16 + swz / 64; C = (st & 1) * 32 + (swz % 64) / 2; }
__host__ __device__ __forceinline__ int perm32(int rho) { const int n = rho >> 4, i = rho & 15; return 8 * (i >> 2) + 4 * n + (i & 3); }

struct Unit { int pm, pn; };
struct Gemm { const bf16_t* A; const bf16_t* Bt; int M, N, K; };

struct StaticOrder {
    int nM, nN, nwg, G, c;
    __host__ __device__ void init(int M, int N, int G_, int c_) { nM = M / BM; nN = N / BM; nwg = nM * nN; G = G_; c = c_; }
    __host__ __device__ bool next(int i, Unit& u) const {
        const long L = (long)i * G + c; if (L >= nwg) return false;
        int wgid = (int)L; { const int q = nwg / NXCD, r = nwg % NXCD, xcd = wgid % NXCD, off = wgid / NXCD; wgid = (xcd < r ? xcd * (q + 1) : r * (q + 1) + (xcd - r) * q) + off; }
        const int nig = WGM * nN, gid = wgid / nig, fm = gid * WGM, gsz = (nM - fm) < WGM ? (nM - fm) : WGM;
        u.pm = fm + ((wgid % nig) % gsz); u.pn = (wgid % nig) / gsz; return true;
    }
    __device__ __forceinline__ void a_ready(const Unit&) const {}
    __device__ __forceinline__ void done(const Unit&) const {}
};

__device__ __forceinline__ unsigned cvt_pk_bf16(float lo, float hi) { unsigned r; asm volatile("v_cvt_pk_bf16_f32 %0, %1, %2" : "=v"(r) : "v"(lo), "v"(hi)); return r; }
template <class Epi, class Sched, bool ALIGN_EPI = false, bool SP2 = false>
__device__ __forceinline__ void gemm_phase(PG8_LAS unsigned char* lds, const Gemm g, const Sched& S, const Epi& E, const int tid) {
    const int wid = __builtin_amdgcn_readfirstlane(tid >> 6), lane = tid & 63, wr = wid >> 2, wc = wid & 3, fr = lane & 15, fq = lane >> 4;
    const int K = g.K, nt = K / BK;
    unsigned voffA[2], voffB[2];
#pragma unroll
    for (int i = 0; i < 2; ++i) { int R, C; stage_rc(tid * 16 + i * 8192, R, C); const int Rb = Epi::PERM ? ((R & ~31) + perm32(R & 31)) : R;
        voffA[i] = (unsigned)(R * K + C) * 2u; voffB[i] = (unsigned)(Rb * K + C) * 2u; }
    const size_t kstep = (size_t)(BK * 2);
    const size_t hstep = (size_t)HALF * K * 2;
    const size_t tstep = 2 * hstep;
    const unsigned ldsw = (unsigned)wid * 1024u;
    const int aoff = lds_byte(wr * 64 + fr, fq * 8), boff = lds_byte(wc * 32 + fr, fq * 8);
#define PG8_SA(b, h) (((b) * 2 + (h)) * HTB)
#define PG8_SB(b, h) ((4 + (b) * 2 + (h)) * HTB)
#define PG8_STAGE(bufoff, gbase, voff) do { _Pragma("unroll") for (int _i = 0; _i < 2; ++_i) \
        __builtin_amdgcn_global_load_lds((const unsigned*)((const char*)(gbase) + (voff)[_i]), (PG8_LAS unsigned*)(lds + (bufoff) + ldsw + _i * 8192), 16, 0, 0); } while (0)
#define PG8_LDA(dst, b, h) do { _Pragma("unroll") for (int m = 0; m < 4; ++m) _Pragma("unroll") for (int k = 0; k < 2; ++k) dst[m][k] = *(const PG8_LAS bf16x8*)(lds + PG8_SA(b, h) + aoff + m * 2048 + k * 1024); } while (0)
#define PG8_LDB(dst, b, h) do { _Pragma("unroll") for (int n = 0; n < 2; ++n) _Pragma("unroll") for (int k = 0; k < 2; ++k) dst[n][k] = *(const PG8_LAS bf16x8*)(lds + PG8_SB(b, h) + boff + n * 2048 + k * 1024); } while (0)
#define PG8_MMA(ai, bj, At, Bt) do { __builtin_amdgcn_s_setprio(1); _Pragma("unroll") for (int m = 0; m < 4; ++m) _Pragma("unroll") for (int n = 0; n < 2; ++n) _Pragma("unroll") for (int k = 0; k < 2; ++k) \
        acc[ai][bj][m][n] = __builtin_amdgcn_mfma_f32_16x16x32_bf16(Bt[n][k], At[m][k], acc[ai][bj][m][n], 0, 0, 0); __builtin_amdgcn_s_setprio(0); } while (0)
#define PG8_WAIT_V(n) asm volatile("s_waitcnt vmcnt(" #n ")" ::: "memory")
#define PG8_WAIT_L(n) asm volatile("s_waitcnt lgkmcnt(" #n ")" ::: "memory")
#define PG8_BAR __builtin_amdgcn_s_barrier()
#define PG8_SCHED __builtin_amdgcn_sched_barrier(0)
    Unit cur, nxt; int ui = 0;
    if (!S.next(0, cur)) return;
    f32x4 acc[2][2][4][2];
#pragma unroll
    for (int a = 0; a < 2; ++a)
#pragma unroll
        for (int b = 0; b < 2; ++b)
#pragma unroll
            for (int m = 0; m < 4; ++m)
#pragma unroll
                for (int n = 0; n < 2; ++n) acc[a][b][m][n] = (f32x4){0.f, 0.f, 0.f, 0.f};
    bf16x8 At[4][2], B0[2][2], B1[2][2];
    const char* cA = (const char*)g.A + (size_t)cur.pm * tstep; const char* cB = (const char*)g.Bt + (size_t)cur.pn * tstep;
    S.a_ready(cur);
    if constexpr (SP2) {
        PG8_STAGE(PG8_SB(0, 0), cB, voffB); PG8_STAGE(PG8_SB(0, 1), cB + hstep, voffB); PG8_STAGE(PG8_SA(0, 0), cA, voffA); PG8_STAGE(PG8_SA(0, 1), cA + hstep, voffA);
        if (wr == 1) PG8_BAR;
        PG8_WAIT_V(2); PG8_BAR;
        PG8_STAGE(PG8_SB(1, 0), cB + kstep, voffB); PG8_STAGE(PG8_SA(1, 0), cA + kstep, voffA); PG8_STAGE(PG8_SB(1, 1), cB + hstep + kstep, voffB);
        PG8_WAIT_V(6); PG8_BAR;
    } else {
        PG8_STAGE(PG8_SB(0, 0), cB, voffB); PG8_STAGE(PG8_SA(0, 0), cA, voffA); PG8_STAGE(PG8_SB(0, 1), cB + hstep, voffB); PG8_STAGE(PG8_SA(0, 1), cA + hstep, voffA);
        if (wr == 1) PG8_BAR;
        PG8_WAIT_V(4); PG8_BAR;
        PG8_STAGE(PG8_SB(1, 0), cB + kstep, voffB); PG8_STAGE(PG8_SA(1, 0), cA + kstep, voffA); PG8_STAGE(PG8_SB(1, 1), cB + hstep + kstep, voffB);
        PG8_WAIT_V(6); PG8_BAR;
    }
    for (;;) {
        const bool has_next = S.next(ui + 1, nxt);
        const char* nA = has_next ? (const char*)g.A + (size_t)nxt.pm * tstep : cA; const char* nB = has_next ? (const char*)g.Bt + (size_t)nxt.pn * tstep : cB;
        for (int t = 0; t < nt; t += 2) {
            const bool last = (t == nt - 2);
            const char* a1 = cA + (size_t)(t + 1) * kstep;
            const char* a2 = last ? nA : cA + (size_t)(t + 2) * kstep; const char* b2 = last ? nB : cB + (size_t)(t + 2) * kstep;
            const char* a3 = a2 + kstep; const char* b3 = b2 + kstep;
            if (last && has_next) S.a_ready(nxt);
            if constexpr (SP2) {
            PG8_LDB(B0, 0, 0); PG8_LDB(B1, 0, 1); PG8_SCHED; PG8_LDA(At, 0, 0); PG8_STAGE(PG8_SA(1, 1), a1 + hstep, voffA);
            PG8_WAIT_V(8); PG8_WAIT_L(0); PG8_BAR; PG8_MMA(0, 0, At, B0); PG8_MMA(0, 1, At, B1); PG8_BAR; PG8_SCHED;
            PG8_LDA(At, 0, 1); PG8_STAGE(PG8_SB(0, 0), b2, voffB); PG8_STAGE(PG8_SB(0, 1), b2 + hstep, voffB); PG8_STAGE(PG8_SA(0, 0), a2, voffA);
            PG8_WAIT_V(8); PG8_WAIT_L(0); PG8_BAR; PG8_MMA(1, 0, At, B0); PG8_MMA(1, 1, At, B1); PG8_BAR; PG8_SCHED;
            PG8_LDB(B0, 1, 0); PG8_LDB(B1, 1, 1); PG8_SCHED; PG8_LDA(At, 1, 0); PG8_STAGE(PG8_SA(0, 1), a2 + hstep, voffA);
            PG8_WAIT_V(8); PG8_WAIT_L(0); PG8_BAR; PG8_MMA(0, 0, At, B0); PG8_MMA(0, 1, At, B1); PG8_BAR; PG8_SCHED;
            PG8_LDA(At, 1, 1); PG8_STAGE(PG8_SB(1, 0), b3, voffB); PG8_STAGE(PG8_SB(1, 1), b3 + hstep, voffB); PG8_STAGE(PG8_SA(1, 0), a3, voffA);
            PG8_WAIT_V(8); PG8_WAIT_L(0); PG8_BAR; PG8_MMA(1, 0, At, B0); PG8_MMA(1, 1, At, B1); PG8_BAR; PG8_SCHED;
            } else {
            PG8_LDB(B0, 0, 0); PG8_SCHED; PG8_LDA(At, 0, 0); PG8_STAGE(PG8_SA(1, 1), a1 + hstep, voffA);
            PG8_WAIT_L(8); PG8_BAR; PG8_WAIT_L(0); PG8_MMA(0, 0, At, B0); PG8_BAR; PG8_SCHED;
            PG8_LDB(B1, 0, 1); PG8_STAGE(PG8_SB(0, 0), b2, voffB);
            PG8_BAR; PG8_WAIT_L(0); PG8_MMA(0, 1, At, B1); PG8_BAR;
            PG8_LDA(At, 0, 1); PG8_STAGE(PG8_SA(0, 0), a2, voffA);
            PG8_BAR; PG8_WAIT_L(0); PG8_MMA(1, 0, At, B0); PG8_BAR; PG8_SCHED;
            PG8_STAGE(PG8_SB(0, 1), b2 + hstep, voffB);
            PG8_WAIT_V(6); PG8_BAR; PG8_MMA(1, 1, At, B1); PG8_BAR;
            PG8_LDB(B0, 1, 0); PG8_SCHED; PG8_LDA(At, 1, 0); PG8_STAGE(PG8_SA(0, 1), a2 + hstep, voffA);
            PG8_WAIT_L(8); PG8_BAR; PG8_WAIT_L(0); PG8_MMA(0, 0, At, B0); PG8_BAR; PG8_SCHED;
            PG8_LDB(B1, 1, 1); PG8_STAGE(PG8_SB(1, 0), b3, voffB);
            PG8_BAR; PG8_WAIT_L(0); PG8_MMA(0, 1, At, B1); PG8_BAR;
            PG8_LDA(At, 1, 1); PG8_STAGE(PG8_SA(1, 0), a3, voffA);
            PG8_BAR; PG8_WAIT_L(0); PG8_MMA(1, 0, At, B0); PG8_BAR; PG8_SCHED;
            PG8_STAGE(PG8_SB(1, 1), b3 + hstep, voffB);
            PG8_WAIT_V(6); PG8_BAR; PG8_MMA(1, 1, At, B1); PG8_BAR;
            }
        }
        if constexpr (ALIGN_EPI) { if (wr == 0) PG8_BAR; }
        if constexpr (!Epi::AFTER_DRAIN) { E(acc, cur, wr, wc, fr, fq); S.done(cur); }
        if (!has_next) break;
#pragma unroll
        for (int a = 0; a < 2; ++a)
#pragma unroll
            for (int b = 0; b < 2; ++b)
#pragma unroll
                for (int m = 0; m < 4; ++m)
#pragma unroll
                    for (int n = 0; n < 2; ++n) acc[a][b][m][n] = (f32x4){0.f, 0.f, 0.f, 0.f};
        cur = nxt; cA = nA; cB = nB; ++ui;
        if constexpr (ALIGN_EPI) { if (wr == 1) PG8_BAR; }
    }
    PG8_WAIT_V(0);
    if constexpr (!ALIGN_EPI) { if (wr == 0) PG8_BAR; }
    PG8_BAR;
    if constexpr (Epi::AFTER_DRAIN) { E.fused(acc, cur, wr, wc, fr, fq, lds, wid, lane); S.done(cur); }
#undef PG8_SA
#undef PG8_SB
#undef PG8_STAGE
#undef PG8_LDA
#undef PG8_LDB
#undef PG8_MMA
#undef PG8_WAIT_V
#undef PG8_WAIT_L
#undef PG8_BAR
#undef PG8_SCHED
}
}

constexpr int SEQ = 16384, BATCH = 2, MTOK = BATCH * SEQ, DM = 1024, DEPTH = 4;
constexpr int NQH = 12, NKVH = 3, NMH = 4, NMEM = 256;
constexpr int QW = 768, KVW = 192, QMW = 256, INW = 1408, INWP = 1536, DFF = 2816, GUW = 5632;
constexpr float EPS = 1e-6f;
constexpr float QSCALE = 0.125f * 1.4426950408889634f;

typedef unsigned short bf16_t;
typedef short bf16x8 __attribute__((ext_vector_type(8)));
typedef float f32x4 __attribute__((ext_vector_type(4)));
typedef float f32x16 __attribute__((ext_vector_type(16)));
typedef unsigned u32x4 __attribute__((ext_vector_type(4)));
typedef unsigned u32x2 __attribute__((ext_vector_type(2)));
#define LAS __attribute__((address_space(3)))

constexpr size_t MiB = 1u << 20;
constexpr size_t WS_TAB = 0;
constexpr size_t WS_MEMN = 2 * MiB;
constexpr size_t WS_KVM = 3 * MiB;
constexpr size_t WS_LSE = 5 * MiB;
constexpr size_t WS_W = 8 * MiB;
constexpr size_t W_LAYER = 23 * MiB, WO_IN = 0, WO_O = 3 * MiB, WO_GU = 5 * MiB, WO_D = 16 * MiB;
constexpr size_t WS_WKV = WS_W + 4 * W_LAYER;
constexpr size_t WS_HB = 104 * MiB;
constexpr size_t WS_OB = 168 * MiB;
constexpr size_t WS_R1 = 232 * MiB;
constexpr size_t WS_Q = WS_R1, WS_K = WS_Q + 48 * MiB, WS_V = WS_K + 12 * MiB, WS_QM = WS_V + 12 * MiB, WS_CTX = WS_QM + 16 * MiB;
constexpr size_t WS_END = WS_R1 + 176 * MiB;

struct Params {
    const float* x; const float* mem; const float* mem_g; const float* w_in; const float* w_kv; const float* w_o;
    const float* g_mix_pre; const float* g_mix_post; const float* sink; const float* qk_g;
    const float* w_gu; const float* w_d; const float* g_ffn_pre; const float* g_ffn_post;
    float* out; unsigned char* ws;
    float invp[8]; float inva[16];
    int ph_lo, ph_hi;
};

__device__ __forceinline__ unsigned f2bf(float f) { unsigned u = __builtin_bit_cast(unsigned, f); return (u + 0x7fffu + ((u >> 16) & 1u)) >> 16; }
__device__ __forceinline__ unsigned pk2(float lo, float hi) { return pg8::cvt_pk_bf16(lo, hi); }
__device__ __forceinline__ float bflo(unsigned w) { return __builtin_bit_cast(float, w << 16); }
__device__ __forceinline__ float bfhi(unsigned w) { return __builtin_bit_cast(float, w & 0xffff0000u); }
__device__ __forceinline__ float wave_sum(float v) {
#pragma unroll
    for (int o = 1; o < 64; o <<= 1) v += __shfl_xor(v, o);
    return v;
}

struct EpiPlain {
    static constexpr bool PERM = true, AFTER_DRAIN = false;
    bf16_t* O; int ldc;
    __device__ __forceinline__ void operator()(const f32x4 (&acc)[2][2][4][2], const pg8::Unit& u, int wr, int wc, int fr, int fq) const {
        const int row0 = u.pm * 256 + wr * 64 + fr, col0 = u.pn * 256 + wc * 32 + 8 * fq;
#pragma unroll
        for (int ai = 0; ai < 2; ++ai)
#pragma unroll
            for (int m = 0; m < 4; ++m) { bf16_t* rowp = O + (size_t)(row0 + ai * 128 + m * 16) * ldc + col0;
#pragma unroll
                for (int bj = 0; bj < 2; ++bj) { const f32x4 v0 = acc[ai][bj][m][0], v1 = acc[ai][bj][m][1];
                    u32x4 w; w.x = pk2(v0[0], v0[1]); w.y = pk2(v0[2], v0[3]); w.z = pk2(v1[0], v1[1]); w.w = pk2(v1[2], v1[3]);
                    *(u32x4*)(rowp + bj * 128) = w; } }
    }
};
struct EpiSwiGLU {
    static constexpr bool PERM = true, AFTER_DRAIN = false;
    bf16_t* O; int ldc;
    __device__ __forceinline__ void operator()(const f32x4 (&acc)[2][2][4][2], const pg8::Unit& u, int wr, int wc, int fr, int fq) const {
        const int row0 = u.pm * 256 + wr * 64 + fr, col0 = u.pn * 128 + wc * 32 + 8 * fq;
#pragma unroll
        for (int ai = 0; ai < 2; ++ai)
#pragma unroll
            for (int m = 0; m < 4; ++m) { bf16_t* rowp = O + (size_t)(row0 + ai * 128 + m * 16) * ldc + col0;
                float r[8];
#pragma unroll
                for (int n = 0; n < 2; ++n)
#pragma unroll
                    for (int j = 0; j < 4; ++j) { const float g = acc[ai][0][m][n][j], up = acc[ai][1][m][n][j];
                        const float s = __builtin_amdgcn_rcpf(1.0f + __builtin_amdgcn_exp2f(-1.4426950408889634f * g));
                        r[n * 4 + j] = g * s * up; }
                u32x4 w; w.x = pk2(r[0], r[1]); w.y = pk2(r[2], r[3]); w.z = pk2(r[4], r[5]); w.w = pk2(r[6], r[7]);
                *(u32x4*)rowp = w; }
    }
};
struct EpiIn {
    static constexpr bool PERM = true, AFTER_DRAIN = false;
    bf16_t *Q, *K, *V, *QM; int kind;
    const float *cosp, *sinp, *cosa, *sina; const float* qkg;
    __device__ __forceinline__ void operator()(const f32x4 (&acc)[2][2][4][2], const pg8::Unit& u, int wr, int wc, int fr, int fq) const {
        const int vh = 4 * u.pn + wc; if (vh >= 22) return;
        const int row0 = u.pm * 256 + wr * 64 + fr;
        const bool isq = vh < 12, isk = vh >= 12 && vh < 15, isv = vh >= 15 && vh < 18;
        bf16_t* base; int ld;
        if (isq) { base = Q + vh * 64; ld = QW; } else if (isk) { base = K + (vh - 12) * 64; ld = KVW; } else if (isv) { base = V + (vh - 15) * 64; ld = KVW; } else { base = QM + (vh - 18) * 64; ld = QMW; }
        const float osc = (isq || (!isk && !isv)) ? QSCALE : 1.0f;
#pragma unroll
        for (int ai = 0; ai < 2; ++ai)
#pragma unroll
            for (int m = 0; m < 4; ++m) {
                const int row = row0 + ai * 128 + m * 16, t = row & (SEQ - 1);
                float v[2][8];
#pragma unroll
                for (int bj = 0; bj < 2; ++bj)
#pragma unroll
                    for (int n = 0; n < 2; ++n)
#pragma unroll
                        for (int j = 0; j < 4; ++j) v[bj][n * 4 + j] = acc[ai][bj][m][n][j];
                if (isq || isk) {
                    if (kind == 1) {
                        float ss = 0.f;
#pragma unroll
                        for (int bj = 0; bj < 2; ++bj)
#pragma unroll
                            for (int e = 0; e < 8; ++e) ss += v[bj][e] * v[bj][e];
                        ss += __shfl_xor(ss, 16); ss += __shfl_xor(ss, 32);
                        const float rs = 1.0f / sqrtf(ss * (1.0f / 64.0f) + EPS);
                        const float* gp = qkg + (isk ? 64 : 0) + 8 * fq;
#pragma unroll
                        for (int bj = 0; bj < 2; ++bj) { const f32x4 g0 = *(const f32x4*)(gp + 32 * bj), g1 = *(const f32x4*)(gp + 32 * bj + 4);
#pragma unroll
                            for (int e = 0; e < 4; ++e) { v[bj][e] *= rs * g0[e]; v[bj][4 + e] *= rs * g1[e]; } }
#pragma unroll
                        for (int bj = 0; bj < 2; ++bj) {
                            const int ti = (bj == 0 ? (t >> 6) : (t & 63)) * 16 + 8 * (fq & 1);
                            const f32x4 c0 = *(const f32x4*)(cosa + ti), c1 = *(const f32x4*)(cosa + ti + 4), s0 = *(const f32x4*)(sina + ti), s1 = *(const f32x4*)(sina + ti + 4);
#pragma unroll
                            for (int e = 0; e < 8; ++e) { const float pr = __shfl_xor(v[bj][e], 32); const float c = e < 4 ? c0[e & 3] : c1[e & 3], s = e < 4 ? s0[e & 3] : s1[e & 3];
                                v[bj][e] = v[bj][e] * c + (fq < 2 ? -pr : pr) * s; }
                        }
                    } else {
                        const f32x4 c0 = *(const f32x4*)(cosp + t * 8), c1 = *(const f32x4*)(cosp + t * 8 + 4), s0 = *(const f32x4*)(sinp + t * 8), s1 = *(const f32x4*)(sinp + t * 8 + 4);
#pragma unroll
                        for (int e = 0; e < 8; ++e) { const float pr = __shfl_xor(v[0][e], 16); const float c = e < 4 ? c0[e & 3] : c1[e & 3], s = e < 4 ? s0[e & 3] : s1[e & 3];
                            const float rv = v[0][e] * c + (fq == 0 ? -pr : pr) * s; v[0][e] = fq < 2 ? rv : v[0][e]; }
                    }
                }
                bf16_t* rowp = base + (size_t)row * ld + 8 * fq;
#pragma unroll
                for (int bj = 0; bj < 2; ++bj) { u32x4 w; w.x = pk2(v[bj][0] * osc, v[bj][1] * osc); w.y = pk2(v[bj][2] * osc, v[bj][3] * osc); w.z = pk2(v[bj][4] * osc, v[bj][5] * osc); w.w = pk2(v[bj][6] * osc, v[bj][7] * osc);
                    *(u32x4*)(rowp + 32 * bj) = w; }
            }
    }
};

__device__ __forceinline__ void transpose_item(const float* W, int K, int ldw, bf16_t* WT, int dst_row0, int src_col0, const float* gk, LAS float* scr, int kb, int lane) {
    const int k0 = 64 * kb;
#pragma unroll 8
    for (int i = 0; i < 32; ++i) { const int kk = 2 * i + (lane >> 5); float val = 0.f;
        if (src_col0 >= 0) { val = W[(size_t)(k0 + kk) * ldw + src_col0 + (lane & 31)]; if (gk) val *= gk[k0 + kk]; }
        scr[kk * 33 + (lane & 31)] = val; }
    asm volatile("s_waitcnt lgkmcnt(0)" ::: "memory");
    const int c = lane & 7;
#pragma unroll
    for (int j = 0; j < 4; ++j) { const int n = (lane >> 3) + 8 * j; const LAS float* s = scr + (8 * c) * 33 + n;
        u32x4 o; o.x = pk2(s[0 * 33], s[1 * 33]); o.y = pk2(s[2 * 33], s[3 * 33]); o.z = pk2(s[4 * 33], s[5 * 33]); o.w = pk2(s[6 * 33], s[7 * 33]);
        *(u32x4*)(WT + (size_t)(dst_row0 + n) * K + k0 + 8 * c) = o; }
    asm volatile("s_waitcnt lgkmcnt(0)" ::: "memory");
}
__device__ __forceinline__ void row_pass(const bf16_t* ob, const float* g, const float* xi, float* xo, bf16_t* hb, const float* g2, int lane) {
    f32x4 x[4];
#pragma unroll
    for (int j = 0; j < 4; ++j) x[j] = *(const f32x4*)(xi + 4 * lane + 256 * j);
    if (ob) {
        f32x4 o[4]; float ss = 0.f;
#pragma unroll
        for (int j = 0; j < 4; ++j) { const u32x2 w = *(const u32x2*)(ob + 4 * lane + 256 * j); o[j] = (f32x4){bflo(w.x), bfhi(w.x), bflo(w.y), bfhi(w.y)};
            ss += (o[j][0] * o[j][0] + o[j][1] * o[j][1]) + (o[j][2] * o[j][2] + o[j][3] * o[j][3]); }
        const float rs = 1.0f / sqrtf(wave_sum(ss) * (1.0f / DM) + EPS);
#pragma unroll
        for (int j = 0; j < 4; ++j) { const f32x4 gv = *(const f32x4*)(g + 4 * lane + 256 * j); x[j] = x[j] + o[j] * rs * gv; }
#pragma unroll
        for (int j = 0; j < 4; ++j) *(f32x4*)(xo + 4 * lane + 256 * j) = x[j];
    }
    if (hb) {
        float ss = 0.f;
#pragma unroll
        for (int j = 0; j < 4; ++j) ss += (x[j][0] * x[j][0] + x[j][1] * x[j][1]) + (x[j][2] * x[j][2] + x[j][3] * x[j][3]);
        const float rs = 1.0f / sqrtf(wave_sum(ss) * (1.0f / DM) + EPS);
#pragma unroll
        for (int j = 0; j < 4; ++j) { f32x4 y = x[j] * rs; if (g2) y = y * *(const f32x4*)(g2 + 4 * lane + 256 * j);
            u32x2 w; w.x = pk2(y[0], y[1]); w.y = pk2(y[2], y[3]); *(u32x2*)(hb + 4 * lane + 256 * j) = w; }
    }
}

constexpr int AT_PITCH = 72, AT_TILE_B = 64 * AT_PITCH * 2, AT_K = 0, AT_V = 2 * AT_TILE_B;
__device__ __forceinline__ int crow(int r, int hi) { return (r & 3) + 8 * (r >> 2) + 4 * hi; }
__device__ __forceinline__ void attn_unit(LAS unsigned char* lds, const bf16_t* Qp, int qpitch, long qrowbase, int qstride, int iq,
                                          const bf16_t* Kp, const bf16_t* Vp, int kpitch, long krowbase, int kstride,
                                          int t_lo, int t_hi, int R, int q0blk,
                                          bf16_t* Op, int opitch, float* lsep, float sink_l2, bool has_sink, const int tid) {
    const int lane = tid & 63, r32 = lane & 31, hi = lane >> 5, wid = __builtin_amdgcn_readfirstlane(tid >> 6);
    const long qrow = qrowbase + (long)iq * qstride;
    bf16x8 qr[4];
#pragma unroll
    for (int d0 = 0; d0 < 4; ++d0) qr[d0] = *(const bf16x8*)(Qp + qrow * qpitch + d0 * 16 + hi * 8);
    float mrun = -1e30f, lrun = 0.f; f32x16 o[2];
#pragma unroll
    for (int r = 0; r < 16; ++r) { o[0][r] = 0.f; o[1][r] = 0.f; }
    const int vpos = (lane & ~15) + 8 * ((lane >> 2) & 1) + (lane & 3) + 4 * ((lane >> 3) & 1);
    u32x4 kreg, vreg;
    { const long kr = krowbase + (long)(t_lo * 64 + lane) * kstride; kreg = *(const u32x4*)(Kp + kr * kpitch + wid * 8); vreg = *(const u32x4*)(Vp + kr * kpitch + wid * 8); }
    for (int t = t_lo; t < t_hi; ++t) {
        const int buf = (t - t_lo) & 1;
        LAS unsigned char* ks = lds + AT_K + buf * AT_TILE_B; LAS unsigned char* vt = lds + AT_V + buf * AT_TILE_B;
        *(LAS u32x4*)(ks + lane * (AT_PITCH * 2) + wid * 16) = kreg;
        { LAS bf16_t* vb = (LAS bf16_t*)vt + (wid * 8) * AT_PITCH + vpos;
          vb[0 * AT_PITCH] = (bf16_t)(vreg.x & 0xffff); vb[1 * AT_PITCH] = (bf16_t)(vreg.x >> 16); vb[2 * AT_PITCH] = (bf16_t)(vreg.y & 0xffff); vb[3 * AT_PITCH] = (bf16_t)(vreg.y >> 16);
          vb[4 * AT_PITCH] = (bf16_t)(vreg.z & 0xffff); vb[5 * AT_PITCH] = (bf16_t)(vreg.z >> 16); vb[6 * AT_PITCH] = (bf16_t)(vreg.w & 0xffff); vb[7 * AT_PITCH] = (bf16_t)(vreg.w >> 16); }
        __syncthreads();
        if (t + 1 < t_hi) { const long kr = krowbase + (long)((t + 1) * 64 + lane) * kstride; kreg = *(const u32x4*)(Kp + kr * kpitch + wid * 8); vreg = *(const u32x4*)(Vp + kr * kpitch + wid * 8); }
        f32x16 p0, p1;
#pragma unroll
        for (int r = 0; r < 16; ++r) { p0[r] = 0.f; p1[r] = 0.f; }
#pragma unroll
        for (int d0 = 0; d0 < 4; ++d0) {
            const bf16x8 b0 = *(const LAS bf16x8*)(ks + r32 * (AT_PITCH * 2) + d0 * 32 + hi * 16);
            const bf16x8 b1 = *(const LAS bf16x8*)(ks + (32 + r32) * (AT_PITCH * 2) + d0 * 32 + hi * 16);
            p0 = __builtin_amdgcn_mfma_f32_32x32x16_bf16(b0, qr[d0], p0, 0, 0, 0);
            p1 = __builtin_amdgcn_mfma_f32_32x32x16_bf16(b1, qr[d0], p1, 0, 0, 0);
        }
        { const int dmax1 = q0blk + 63 - 64 * t, dmax2 = 64 * t + 63 - q0blk;
          if (dmax1 > R || dmax2 > R) {
#pragma unroll
              for (int r = 0; r < 16; ++r) { const int kv = 64 * t + crow(r, hi); int d = kv - iq; d = d < 0 ? -d : d; if (d > R) p0[r] = -1e30f; int d2 = kv + 32 - iq; d2 = d2 < 0 ? -d2 : d2; if (d2 > R) p1[r] = -1e30f; }
          } }
        float mt = fmaxf(p0[0], p1[0]);
#pragma unroll
        for (int r = 1; r < 16; ++r) mt = fmaxf(mt, fmaxf(p0[r], p1[r]));
        mt = fmaxf(mt, __shfl_xor(mt, 32));
        const float mnew = fmaxf(mrun, mt), alpha = __builtin_amdgcn_exp2f(mrun - mnew); mrun = mnew;
        float sum = 0.f;
#pragma unroll
        for (int r = 0; r < 16; ++r) { p0[r] = __builtin_amdgcn_exp2f(p0[r] - mnew); p1[r] = __builtin_amdgcn_exp2f(p1[r] - mnew); sum += p0[r] + p1[r]; }
        lrun = lrun * alpha + sum;
#pragma unroll
        for (int r = 0; r < 16; ++r) { o[0][r] *= alpha; o[1][r] *= alpha; }
        u32x4 pw[4];
        pw[0] = (u32x4){pk2(p0[0], p0[1]), pk2(p0[2], p0[3]), pk2(p0[4], p0[5]), pk2(p0[6], p0[7])};
        pw[1] = (u32x4){pk2(p0[8], p0[9]), pk2(p0[10], p0[11]), pk2(p0[12], p0[13]), pk2(p0[14], p0[15])};
        pw[2] = (u32x4){pk2(p1[0], p1[1]), pk2(p1[2], p1[3]), pk2(p1[4], p1[5]), pk2(p1[6], p1[7])};
        pw[3] = (u32x4){pk2(p1[8], p1[9]), pk2(p1[10], p1[11]), pk2(p1[12], p1[13]), pk2(p1[14], p1[15])};
#pragma unroll
        for (int d0 = 0; d0 < 2; ++d0)
#pragma unroll
            for (int ksx = 0; ksx < 4; ++ksx) {
                const bf16x8 vf = *(const LAS bf16x8*)(vt + (32 * d0 + r32) * (AT_PITCH * 2) + ksx * 32 + hi * 16);
                o[d0] = __builtin_amdgcn_mfma_f32_32x32x16_bf16(vf, __builtin_bit_cast(bf16x8, pw[ksx]), o[d0], 0, 0, 0);
            }
    }
    lrun += __shfl_xor(lrun, 32);
    if (has_sink) lrun += __builtin_amdgcn_exp2f(sink_l2 - mrun);
    const float inv = 1.0f / lrun;
    bf16_t* orow = Op + qrow * opitch;
#pragma unroll
    for (int d0 = 0; d0 < 2; ++d0)
#pragma unroll
        for (int rq = 0; rq < 4; ++rq) { u32x2 w; w.x = pk2(o[d0][4 * rq] * inv, o[d0][4 * rq + 1] * inv); w.y = pk2(o[d0][4 * rq + 2] * inv, o[d0][4 * rq + 3] * inv);
            *(u32x2*)(orow + 32 * d0 + 8 * rq + 4 * hi) = w; }
    if (lsep && hi == 0) lsep[qrow * 12] = mrun + __builtin_log2f(lrun);
    __syncthreads();
}

constexpr int LDS_BYTES = 131072 + 1024;
constexpr int NPHASES = 1 + 4 * 7 + 1;

__device__ __forceinline__ float lse_weight(const float* L, int head) {
    const int j = head & 3; const float a = L[j], b = L[4 + j], c = L[8 + j], mine = L[head];
    const float m = fmaxf(a, fmaxf(b, c));
    const float s = __builtin_amdgcn_exp2f(a - m) + __builtin_amdgcn_exp2f(b - m) + __builtin_amdgcn_exp2f(c - m);
    return __builtin_amdgcn_exp2f(mine - m) / s;
}

__global__ void __launch_bounds__(512, 2) fwd_megakernel(Params p) {
    extern __shared__ __attribute__((aligned(16))) unsigned char lds_raw[];
    LAS unsigned char* lds = (LAS unsigned char*)lds_raw;
    cg::grid_group grid = cg::this_grid();
    const int tid = threadIdx.x, wid = __builtin_amdgcn_readfirstlane(tid >> 6);
    const int G = gridDim.x, gw = blockIdx.x * 8 + wid, NGW = G * 8;
    unsigned char* ws = p.ws;
    float* cosp = (float*)(ws + WS_TAB); float* sinp = cosp + SEQ * 8; float* cosa = sinp + SEQ * 8; float* sina = cosa + 256 * 16;
    bf16_t* MEMN = (bf16_t*)(ws + WS_MEMN); bf16_t* KVM = (bf16_t*)(ws + WS_KVM); float* LSE = (float*)(ws + WS_LSE);
    bf16_t* WKV = (bf16_t*)(ws + WS_WKV); bf16_t* HB = (bf16_t*)(ws + WS_HB); bf16_t* OB = (bf16_t*)(ws + WS_OB);
    bf16_t* Qb = (bf16_t*)(ws + WS_Q); bf16_t* Kb = (bf16_t*)(ws + WS_K); bf16_t* Vb = (bf16_t*)(ws + WS_V); bf16_t* QMb = (bf16_t*)(ws + WS_QM);
    bf16_t* CTX = (bf16_t*)(ws + WS_CTX); bf16_t* ACT = (bf16_t*)(ws + WS_R1);
    int ph = 0;
#define PH_ON (ph >= p.ph_lo && ph < p.ph_hi)
#define LAUNDER int tl_ = tid; asm volatile("" : "+v"(tl_)); const int lane = tl_ & 63; (void)lane
#define PH_END do { if (PH_ON && ph + 1 < p.ph_hi) grid.sync(); ++ph; } while (0)

    if (PH_ON) { LAUNDER;
        LAS float* scr = (LAS float*)(lds + wid * 16384);
        constexpr int I_IN = 16 * 48, I_O = 16 * 32, I_GU = 16 * 176, I_D = 44 * 32, I_KV = 16 * 16, I_L = I_IN + I_O + I_GU + I_D + I_KV;
        for (int it = gw; it < DEPTH * I_L; it += NGW) {
            const int l = it / I_L; int r = it % I_L;
            bf16_t* wl = (bf16_t*)(ws + WS_W + (size_t)l * W_LAYER);
            if (r < I_IN) { const int kb = r / 48, nb = r % 48, R0 = 32 * nb, tile = R0 >> 8, c = R0 & 255, vh = 4 * tile + ((c >> 5) & 3), src = vh < 22 ? 64 * vh + 32 * (c >> 7) : -1;
                transpose_item(p.w_in + (size_t)l * DM * INW, DM, INW, (bf16_t*)((unsigned char*)wl + WO_IN), R0, src, p.g_mix_pre + l * DM, scr, kb, lane); continue; }
            r -= I_IN;
            if (r < I_O) { const int kb = r / 32, nb = r % 32;
                transpose_item(p.w_o + (size_t)l * DM * DM, DM, DM, (bf16_t*)((unsigned char*)wl + WO_O), 32 * nb, 32 * nb, nullptr, scr, kb, lane); continue; }
            r -= I_O;
            if (r < I_GU) { const int kb = r / 176, nb = r % 176, R0 = 32 * nb, tile = R0 >> 8, c = R0 & 255, src = ((c >> 7) ? DFF : 0) + 128 * tile + (c & 127);
                transpose_item(p.w_gu + (size_t)l * DM * GUW, DM, GUW, (bf16_t*)((unsigned char*)wl + WO_GU), R0, src, p.g_ffn_pre + l * DM, scr, kb, lane); continue; }
            r -= I_GU;
            if (r < I_D) { const int kb = r / 32, nb = r % 32;
                transpose_item(p.w_d + (size_t)l * DFF * DM, DFF, DM, (bf16_t*)((unsigned char*)wl + WO_D), 32 * nb, 32 * nb, nullptr, scr, kb, lane); continue; }
            r -= I_D;
            { const int kb = r / 16, nb = r % 16;
                transpose_item(p.w_kv + (size_t)l * DM * 512, DM, 512, WKV + (size_t)l * 512 * DM, 32 * nb, 32 * nb, nullptr, scr, kb, lane); }
        }
        for (int e = blockIdx.x * 512 + tid; e < SEQ * 8; e += G * 512) {
            { const int t = e >> 3, i = e & 7; const float ang = (float)t * p.invp[i]; cosp[e] = cosf(ang); sinp[e] = sinf(ang); }
            if (e < 256 * 16) { const int t = e >> 4, i = e & 15; const float ang = (float)t * p.inva[i]; cosa[e] = cosf(ang); sina[e] = sinf(ang); }
        }
        for (int m = gw; m < BATCH * NMEM; m += NGW) row_pass(nullptr, nullptr, p.mem + (size_t)m * DM, nullptr, MEMN + (size_t)m * DM, p.mem_g, lane);
        for (int m = gw; m < MTOK; m += NGW) row_pass(nullptr, nullptr, p.x + (size_t)m * DM, nullptr, HB + (size_t)m * DM, nullptr, lane);
    }
    PH_END;

    for (int l = 0; l < DEPTH; ++l) {
        const int kind = l % 3;
        unsigned char* wl = ws + WS_W + (size_t)l * W_LAYER;
        if (PH_ON) { LAUNDER;
            if (l == 0) { pg8::Gemm g{MEMN, WKV, BATCH * NMEM, DEPTH * 512, DM}; pg8::StaticOrder S; S.init(BATCH * NMEM, DEPTH * 512, G, (int)blockIdx.x);
                EpiPlain E{KVM, DEPTH * 512}; pg8::gemm_phase<EpiPlain, pg8::StaticOrder, false, true>(lds, g, S, E, tl_); }
            pg8::Gemm g{HB, (const bf16_t*)(wl + WO_IN), MTOK, INWP, DM}; pg8::StaticOrder S; S.init(MTOK, INWP, G, (int)blockIdx.x);
            EpiIn E{Qb, Kb, Vb, QMb, kind, cosp, sinp, cosa, sina, p.qk_g + (l / 3) * 128};
            pg8::gemm_phase<EpiIn, pg8::StaticOrder, true, true>(lds, g, S, E, tl_);
        }
        PH_END;
        if (PH_ON) { LAUNDER;
            const int r32 = lane & 31;
            for (int u = blockIdx.x; u < 2048; u += G) {
                const bf16_t *Qp, *Kp, *Vp; bf16_t* Op; float* lsep = nullptr; int qpitch, kpitch, stride = 1, iq, tl, th, R = 1 << 30, q0 = 0; long qrb, krb; float sk = 0.f; bool hs = false;
                if (u < 1536) {
                    const int b = u / 768, rem = u % 768, kvh = rem >> 8, w = rem & 255, j = wid & 3, half = wid >> 2, head = 4 * kvh + j;
                    Qp = Qb + head * 64; qpitch = QW; Kp = Kb + kvh * 64; Vp = Vb + kvh * 64; kpitch = KVW; Op = CTX + head * 64;
                    int qb = w; qrb = (long)b * SEQ; tl = 0; th = 256;
                    if (kind == 2) { const int dil = 1 << (2 * kvh), nblk = 256 / dil, res = w / nblk; qb = w % nblk; stride = dil; qrb += res;
                        tl = qb - 1 < 0 ? 0 : qb - 1; th = qb + 2 > nblk ? nblk : qb + 2; R = 64; lsep = LSE + head; }
                    else if (kind == 0) { tl = qb - 2 < 0 ? 0 : qb - 2; th = qb + 3 > 256 ? 256 : qb + 3; R = 128; sk = p.sink[(l / 3) * NQH + head] * 1.4426950408889634f; hs = true; }
                    krb = qrb; q0 = 64 * qb; iq = q0 + 32 * half + r32;
                } else {
                    const int v = u - 1536, b = v >> 8, h = (v >> 6) & 3, qb = v & 63;
                    Qp = QMb + h * 64; qpitch = QMW; Kp = KVM + l * 512 + h * 64; Vp = Kp + 256; kpitch = DEPTH * 512; Op = CTX + QW + h * 64;
                    qrb = (long)b * SEQ; krb = (long)b * NMEM; tl = 0; th = 4; iq = 256 * qb + 32 * wid + r32;
                }
                attn_unit(lds, Qp, qpitch, qrb, stride, iq, Kp, Vp, kpitch, krb, stride, tl, th, R, q0, Op, DM, lsep, sk, hs, tl_);
            }
        }
        PH_END;
        if (kind == 2) {
            if (PH_ON) { LAUNDER;
                for (int m = gw; m < MTOK; m += NGW) { const float* L = LSE + (size_t)m * 12; bf16_t* rowp = CTX + (size_t)m * DM;
#pragma unroll
                    for (int cc = 0; cc < 2; ++cc) { const int c = lane + 64 * cc; if (c < 96) { const float wgt = lse_weight(L, c >> 3);
                        u32x4 v = *(u32x4*)(rowp + c * 8);
                        v.x = pk2(bflo(v.x) * wgt, bfhi(v.x) * wgt); v.y = pk2(bflo(v.y) * wgt, bfhi(v.y) * wgt); v.z = pk2(bflo(v.z) * wgt, bfhi(v.z) * wgt); v.w = pk2(bflo(v.w) * wgt, bfhi(v.w) * wgt);
                        *(u32x4*)(rowp + c * 8) = v; } } }
            }
            PH_END;
        }
        if (PH_ON) { LAUNDER; pg8::Gemm g{CTX, (const bf16_t*)(wl + WO_O), MTOK, DM, DM}; pg8::StaticOrder S; S.init(MTOK, DM, G, (int)blockIdx.x);
            EpiPlain E{OB, DM}; pg8::gemm_phase<EpiPlain, pg8::StaticOrder, true, true>(lds, g, S, E, tl_); }
        PH_END;
        if (PH_ON) { LAUNDER; const float* xi = l == 0 ? p.x : p.out;
            for (int m = gw; m < MTOK; m += NGW) row_pass(OB + (size_t)m * DM, p.g_mix_post + l * DM, xi + (size_t)m * DM, p.out + (size_t)m * DM, HB + (size_t)m * DM, nullptr, lane); }
        PH_END;
        if (PH_ON) { LAUNDER; pg8::Gemm g{HB, (const bf16_t*)(wl + WO_GU), MTOK, GUW, DM}; pg8::StaticOrder S; S.init(MTOK, GUW, G, (int)blockIdx.x);
            EpiSwiGLU E{ACT, DFF}; pg8::gemm_phase<EpiSwiGLU, pg8::StaticOrder, true, true>(lds, g, S, E, tl_); }
        PH_END;
        if (PH_ON) { LAUNDER; pg8::Gemm g{ACT, (const bf16_t*)(wl + WO_D), MTOK, DM, DFF}; pg8::StaticOrder S; S.init(MTOK, DM, G, (int)blockIdx.x);
            EpiPlain E{OB, DM}; pg8::gemm_phase<EpiPlain, pg8::StaticOrder, true, true>(lds, g, S, E, tl_); }
        PH_END;
        if (PH_ON) { LAUNDER; for (int m = gw; m < MTOK; m += NGW) row_pass(OB + (size_t)m * DM, p.g_ffn_post + l * DM, p.out + (size_t)m * DM, p.out + (size_t)m * DM, l + 1 < DEPTH ? HB + (size_t)m * DM : nullptr, nullptr, lane); }
        PH_END;
    }
#undef PH_ON
#undef PH_END
}

extern "C" void kernel_launch(void* const* d_in, const int* in_sizes, int n_in, void* d_out, int out_size, void* d_ws, size_t ws_size, hipStream_t stream) {
    static int grid = 0;
    if (grid == 0) {
        if (n_in != 14 || in_sizes[0] != MTOK * DM || out_size != MTOK * DM || ws_size < WS_END) { fprintf(stderr, "kernel_launch: unexpected shapes (n_in %d, in0 %d, out %d, ws %zu)\n", n_in, n_in > 0 ? in_sizes[0] : -1, out_size, ws_size); grid = -1; return; }
        int dev = 0, cus = 0, per_cu = 0;
        hipGetDevice(&dev); hipDeviceGetAttribute(&cus, hipDeviceAttributeMultiprocessorCount, dev);
        if (hipFuncSetAttribute((const void*)fwd_megakernel, hipFuncAttributeMaxDynamicSharedMemorySize, LDS_BYTES) != hipSuccess) { fprintf(stderr, "kernel_launch: hipFuncSetAttribute failed\n"); grid = -1; return; }
        hipOccupancyMaxActiveBlocksPerMultiprocessor(&per_cu, (const void*)fwd_megakernel, 512, LDS_BYTES);
        (void)hipGetLastError();
        if (per_cu < 1) fprintf(stderr, "kernel_launch: occupancy query says %d blocks/CU\n", per_cu);
        grid = cus;
    }
    if (grid < 0) return;
    Params p{};
    p.x = (const float*)d_in[0]; p.mem = (const float*)d_in[1]; p.mem_g = (const float*)d_in[2]; p.w_in = (const float*)d_in[3]; p.w_kv = (const float*)d_in[4]; p.w_o = (const float*)d_in[5];
    p.g_mix_pre = (const float*)d_in[6]; p.g_mix_post = (const float*)d_in[7]; p.sink = (const float*)d_in[8]; p.qk_g = (const float*)d_in[9];
    p.w_gu = (const float*)d_in[10]; p.w_d = (const float*)d_in[11]; p.g_ffn_pre = (const float*)d_in[12]; p.g_ffn_post = (const float*)d_in[13];
    p.out = (float*)d_out; p.ws = (unsigned char*)d_ws;
    for (int i = 0; i < 8; ++i) p.invp[i] = powf(500000.0f, -((float)(2 * i) / 16.0f));
    for (int i = 0; i < 16; ++i) p.inva[i] = powf(10000.0f, -((float)(2 * i) / 32.0f));
    p.ph_lo = 0; p.ph_hi = NPHASES;
    void* args[] = {&p};
    hipError_t e = hipLaunchCooperativeKernel((const void*)fwd_megakernel, dim3(grid), dim3(512), args, LDS_BYTES, stream);
    if (e != hipSuccess) fprintf(stderr, "cooperative launch failed: %s (grid %d)\n", hipGetErrorString(e), grid);
}
```

```cpp
#include <hip/hip_runtime.h>
#include <hip/hip_cooperative_groups.h>
#include <cstdio>
#include <cstdint>
#include <cmath>
namespace cg = cooperative_groups;
namespace pg8 {
#define PG8_LAS __attribute__((address_space(3)))
typedef unsigned short bf16_t;
typedef short bf16x8 __attribute__((ext_vector_type(8)));
typedef float f32x4 __attribute__((ext_vector_type(4)));
typedef unsigned u32x4 __attribute__((ext_vector_type(4)));
constexpr int BM = 256, BK = 64, HALF = 128, HTB = HALF * BK * 2  , STAGE_BYTES = 8 * HTB, NXCD = 8, WGM = 8;

__host__ __device__ __forceinline__ int lds_byte(int r, int c) { const int st = (r >> 4) * 2 + (c >> 5), rr = r & 15, cc = c & 31, ob = rr * 64 + cc * 2; return st * 1024 + (ob ^ (((ob >> 9) & 1) << 5)); }
__host__ __device__ __forceinline__ void stage_rc(int b, int& R, int& C) { const int st = b / 1024, sb = b % 1024, swz = sb ^ (((sb >> 9) & 1) << 5); R = (st >> 1) * 16 + swz / 64; C = (st & 1) * 32 + (swz % 64) / 2; }
__host__ __device__ __forceinline__ int perm32(int rho) { const int n = rho >> 4, i = rho & 15; return 8 * (i >> 2) + 4 * n + (i & 3); }

struct Unit { int pm, pn; };
struct Gemm { const bf16_t* A; const bf16_t* Bt; int M, N, K; };

struct StaticOrder {
    int nM, nN, nwg, G, c;
    __host__ __device__ void init(int M, int N, int G_, int c_) { nM = M / BM; nN = N / BM; nwg = nM * nN; G = G_; c = c_; }
    __host__ __device__ bool next(int i, Unit& u) const {
        const long L = (long)i * G + c; if (L >= nwg) return false;
        int wgid = (int)L; { const int q = nwg / NXCD, r = nwg % NXCD, xcd = wgid % NXCD, off = wgid / NXCD; wgid = (xcd < r ? xcd * (q + 1) : r * (q + 1) + (xcd - r) * q) + off; }
        const int nig = WGM * nN, gid = wgid / nig, fm = gid * WGM, gsz = (nM - fm) < WGM ? (nM - fm) : WGM;
        u.pm = fm + ((wgid % nig) % gsz); u.pn = (wgid % nig) / gsz; return true;
    }
    __device__ __forceinline__ void a_ready(const Unit&) const {}
    __device__ __forceinline__ void done(const Unit&) const {}
};

__device__ __forceinline__ unsigned cvt_pk_bf16(float lo, float hi) { unsigned r; asm volatile("v_cvt_pk_bf16_f32 %0, %1, %2" : "=v"(r) : "v"(lo), "v"(hi)); return r; }
template <class Epi, class Sched, bool ALIGN_EPI = false, bool SP2 = false>
__device__ __forceinline__ void gemm_phase(PG8_LAS unsigned char* lds, const Gemm g, const Sched& S, const Epi& E, const int tid) {
    const int wid = __builtin_amdgcn_readfirstlane(tid >> 6), lane = tid & 63, wr = wid >> 2, wc = wid & 3, fr = lane & 15, fq = lane >> 4;
    const int K = g.K, nt = K / BK;
    unsigned voffA[2], voffB[2];
#pragma unroll
    for (int i = 0; i < 2; ++i) { int R, C; stage_rc(tid * 16 + i * 8192, R, C); const int Rb = Epi::PERM ? ((R & ~31) + perm32(R & 31)) : R;
        voffA[i] = (unsigned)(R * K + C) * 2u; voffB[i] = (unsigned)(Rb * K + C) * 2u; }
    const size_t kstep = (size_t)(BK * 2);
    const size_t hstep = (size_t)HALF * K * 2;
    const size_t tstep = 2 * hstep;
    const unsigned ldsw = (unsigned)wid * 1024u;
    const int aoff = lds_byte(wr * 64 + fr, fq * 8), boff = lds_byte(wc * 32 + fr, fq * 8);
#define PG8_SA(b, h) (((b) * 2 + (h)) * HTB)
#define PG8_SB(b, h) ((4 + (b) * 2 + (h)) * HTB)
#define PG8_STAGE(bufoff, gbase, voff) do { _Pragma("unroll") for (int _i = 0; _i < 2; ++_i) \
        __builtin_amdgcn_global_load_lds((const unsigned*)((const char*)(gbase) + (voff)[_i]), (PG8_LAS unsigned*)(lds + (bufoff) + ldsw + _i * 8192), 16, 0, 0); } while (0)
#define PG8_LDA(dst, b, h) do { _Pragma("unroll") for (int m = 0; m < 4; ++m) _Pragma("unroll") for (int k = 0; k < 2; ++k) dst[m][k] = *(const PG8_LAS bf16x8*)(lds + PG8_SA(b, h) + aoff + m * 2048 + k * 1024); } while (0)
#define PG8_LDB(dst, b, h) do { _Pragma("unroll") for (int n = 0; n < 2; ++n) _Pragma("unroll") for (int k = 0; k < 2; ++k) dst[n][k] = *(const PG8_LAS bf16x8*)(lds + PG8_SB(b, h) + boff + n * 2048 + k * 1024); } while (0)
#define PG8_MMA(ai, bj, At, Bt) do { __builtin_amdgcn_s_setprio(1); _Pragma("unroll") for (int m = 0; m < 4; ++m) _Pragma("unroll") for (int n = 0; n < 2; ++n) _Pragma("unroll") for (int k = 0; k < 2; ++k) \
        acc[ai][bj][m][n] = __builtin_amdgcn_mfma_f32_16x16x32_bf16(Bt[n][k], At[m][k], acc[ai][bj][m][n], 0, 0, 0); __builtin_amdgcn_s_setprio(0); } while (0)
#define PG8_WAIT_V(n) asm volatile("s_waitcnt vmcnt(" #n ")" ::: "memory")
#define PG8_WAIT_L(n) asm volatile("s_waitcnt lgkmcnt(" #n ")" ::: "memory")
#define PG8_BAR __builtin_amdgcn_s_barrier()
#define PG8_SCHED __builtin_amdgcn_sched_barrier(0)
    Unit cur, nxt; int ui = 0;
    if (!S.next(0, cur)) return;
    f32x4 acc[2][2][4][2];
#pragma unroll
    for (int a = 0; a < 2; ++a)
#pragma unroll
        for (int b = 0; b < 2; ++b)
#pragma unroll
            for (int m = 0; m < 4; ++m)
#pragma unroll
                for (int n = 0; n < 2; ++n) acc[a][b][m][n] = (f32x4){0.f, 0.f, 0.f, 0.f};
    bf16x8 At[4][2], B0[2][2], B1[2][2];
    const char* cA = (const char*)g.A + (size_t)cur.pm * tstep; const char* cB = (const char*)g.Bt + (size_t)cur.pn * tstep;
    S.a_ready(cur);
    if constexpr (SP2) {
        PG8_STAGE(PG8_SB(0, 0), cB, voffB); PG8_STAGE(PG8_SB(0, 1), cB + hstep, voffB); PG8_STAGE(PG8_SA(0, 0), cA, voffA); PG8_STAGE(PG8_SA(0, 1), cA + hstep, voffA);
        if (wr == 1) PG8_BAR;
        PG8_WAIT_V(2); PG8_BAR;
        PG8_STAGE(PG8_SB(1, 0), cB + kstep, voffB); PG8_STAGE(PG8_SA(1, 0), cA + kstep, voffA); PG8_STAGE(PG8_SB(1, 1), cB + hstep + kstep, voffB);
        PG8_WAIT_V(6); PG8_BAR;
    } else {
        PG8_STAGE(PG8_SB(0, 0), cB, voffB); PG8_STAGE(PG8_SA(0, 0), cA, voffA); PG8_STAGE(PG8_SB(0, 1), cB + hstep, voffB); PG8_STAGE(PG8_SA(0, 1), cA + hstep, voffA);
        if (wr == 1) PG8_BAR;
        PG8_WAIT_V(4); PG8_BAR;
        PG8_STAGE(PG8_SB(1, 0), cB + kstep, voffB); PG8_STAGE(PG8_SA(1, 0), cA + kstep, voffA); PG8_STAGE(PG8_SB(1, 1), cB + hstep + kstep, voffB);
        PG8_WAIT_V(6); PG8_BAR;
    }
    for (;;) {
        const bool has_next = S.next(ui + 1, nxt);
        const char* nA = has_next ? (const char*)g.A + (size_t)nxt.pm * tstep : cA; const char* nB = has_next ? (const char*)g.Bt + (size_t)nxt.pn * tstep : cB;
        for (int t = 0; t < nt; t += 2) {
            const bool last = (t == nt - 2);
            const char* a1 = cA + (size_t)(t + 1) * kstep;
            const char* a2 = last ? nA : cA + (size_t)(t + 2) * kstep; const char* b2 = last ? nB : cB + (size_t)(t + 2) * kstep;
            const char* a3 = a2 + kstep; const char* b3 = b2 + kstep;
            if (last && has_next) S.a_ready(nxt);
            if constexpr (SP2) {
            PG8_LDB(B0, 0, 0); PG8_LDB(B1, 0, 1); PG8_SCHED; PG8_LDA(At, 0, 0); PG8_STAGE(PG8_SA(1, 1), a1 + hstep, voffA);
            PG8_WAIT_V(8); PG8_WAIT_L(0); PG8_BAR; PG8_MMA(0, 0, At, B0); PG8_MMA(0, 1, At, B1); PG8_BAR; PG8_SCHED;
            PG8_LDA(At, 0, 1); PG8_STAGE(PG8_SB(0, 0), b2, voffB); PG8_STAGE(PG8_SB(0, 1), b2 + hstep, voffB); PG8_STAGE(PG8_SA(0, 0), a2, voffA);
            PG8_WAIT_V(8); PG8_WAIT_L(0); PG8_BAR; PG8_MMA(1, 0, At, B0); PG8_MMA(1, 1, At, B1); PG8_BAR; PG8_SCHED;
            PG8_LDB(B0, 1, 0); PG8_LDB(B1, 1, 1); PG8_SCHED; PG8_LDA(At, 1, 0); PG8_STAGE(PG8_SA(0, 1), a2 + hstep, voffA);
            PG8_WAIT_V(8); PG8_WAIT_L(0); PG8_BAR; PG8_MMA(0, 0, At, B0); PG8_MMA(0, 1, At, B1); PG8_BAR; PG8_SCHED;
            PG8_LDA(At, 1, 1); PG8_STAGE(PG8_SB(1, 0), b3, voffB); PG8_STAGE(PG8_SB(1, 1), b3 + hstep, voffB); PG8_STAGE(PG8_SA(1, 0), a3, voffA);
            PG8_WAIT_V(8); PG8_WAIT_L(0); PG8_BAR; PG8_MMA(1, 0, At, B0); PG8_MMA(1, 1, At, B1); PG8_BAR; PG8_SCHED;
            } else {
            PG8_LDB(B0, 0, 0); PG8_SCHED; PG8_LDA(At, 0, 0); PG8_STAGE(PG8_SA(1, 1), a1 + hstep, voffA);
            PG8_WAIT_L(8); PG8_BAR; PG8_WAIT_L(0); PG8_MMA(0, 0, At, B0); PG8_BAR; PG8_SCHED;
            PG8_LDB(B1, 0, 1); PG8_STAGE(PG8_SB(0, 0), b2, voffB);
            PG8_BAR; PG8_WAIT_L(0); PG8_MMA(0, 1, At, B1); PG8_BAR;
            PG8_LDA(At, 0, 1); PG8_STAGE(PG8_SA(0, 0), a2, voffA);
            PG8_BAR; PG8_WAIT_L(0); PG8_MMA(1, 0, At, B0); PG8_BAR; PG8_SCHED;
            PG8_STAGE(PG8_SB(0, 1), b2 + hstep, voffB);
            PG8_WAIT_V(6); PG8_BAR; PG8_MMA(1, 1, At, B1); PG8_BAR;
            PG8_LDB(B0, 1, 0); PG8_SCHED; PG8_LDA(At, 1, 0); PG8_STAGE(PG8_SA(0, 1), a2 + hstep, voffA);
            PG8_WAIT_L(8); PG8_BAR; PG8_WAIT_L(0); PG8_MMA(0, 0, At, B0); PG8_BAR; PG8_SCHED;
            PG8_LDB(B1, 1, 1); PG8_STAGE(PG8_SB(1, 0), b3, voffB);
            PG8_BAR; PG8_WAIT_L(0); PG8_MMA(0, 1, At, B1); PG8_BAR;
            PG8_LDA(At, 1, 1); PG8_STAGE(PG8_SA(1, 0), a3, voffA);
            PG8_BAR; PG8_WAIT_L(0); PG8_MMA(1, 0, At, B0); PG8_BAR; PG8_SCHED;
            PG8_STAGE(PG8_SB(1, 1), b3 + hstep, voffB);
            PG8_WAIT_V(6); PG8_BAR; PG8_MMA(1, 1, At, B1); PG8_BAR;
            }
        }
        if constexpr (ALIGN_EPI) { if (wr == 0) PG8_BAR; }
        if constexpr (!Epi::AFTER_DRAIN) { E(acc, cur, wr, wc, fr, fq); S.done(cur); }
        if (!has_next) break;
#pragma unroll
        for (int a = 0; a < 2; ++a)
#pragma unroll
            for (int b = 0; b < 2; ++b)
#pragma unroll
                for (int m = 0; m < 4; ++m)
#pragma unroll
                    for (int n = 0; n < 2; ++n) acc[a][b][m][n] = (f32x4){0.f, 0.f, 0.f, 0.f};
        cur = nxt; cA = nA; cB = nB; ++ui;
        if constexpr (ALIGN_EPI) { if (wr == 1) PG8_BAR; }
    }
    PG8_WAIT_V(0);
    if constexpr (!ALIGN_EPI) { if (wr == 0) PG8_BAR; }
    PG8_BAR;
    if constexpr (Epi::AFTER_DRAIN) { E.fused(acc, cur, wr, wc, fr, fq, lds, wid, lane); S.done(cur); }
#undef PG8_SA
#undef PG8_SB
#undef PG8_STAGE
#undef PG8_LDA
#undef PG8_LDB
#undef PG8_MMA
#undef PG8_WAIT_V
#undef PG8_WAIT_L
#undef PG8_BAR
#undef PG8_SCHED
}
}
namespace attn_body {
__device__ __forceinline__ unsigned f2bf_dev(float f){unsigned u=__builtin_bit_cast(unsigned,f);return (u+0x7fffu+((u>>16)&1u))>>16;}
using bf16=unsigned short;
using bf16x8=__attribute__((ext_vector_type(8)))short;
using s16x4=__attribute__((ext_vector_type(4)))short;
using f32x16=__attribute__((ext_vector_type(16)))float;
using u32x4=__attribute__((ext_vector_type(4)))unsigned;
constexpr int D=64;
constexpr int NW=8,QBLK=32,KVBLK=64;
__device__ __forceinline__ int crow(int r,int hi){return (r&3)+8*(r>>2)+4*hi;}
#define SBAR() __builtin_amdgcn_sched_barrier(0)
constexpr int NSLOT=3, SLOTB=8192;
constexpr int LDS_K=0, LDS_V=NSLOT*SLOTB, LDS_WS=2*NSLOT*SLOTB, LDS_OST=LDS_WS+NW*64*4, LDS_BYTES=LDS_OST+NW*4096;
constexpr float C2=0.125f*1.4426950408889634f;
__device__ __forceinline__ void glds16(const void*gsrc,unsigned lds_dst){unsigned keep;
  asm volatile("s_mov_b32 %0, m0\n\ts_mov_b32 m0, %2\n\ts_nop 0\n\tglobal_load_lds_dwordx4 %1, off\n\ts_mov_b32 m0, %0":"=&s"(keep):"v"(gsrc),"s"(lds_dst):"memory");}
__device__ __forceinline__ float max3f(float a,float b,float c){float r;asm("v_max3_f32 %0, %1, %2, %3":"=v"(r):"v"(a),"v"(b),"v"(c));return r;}
__device__ __forceinline__ float max2f(float a,float b){float r;asm("v_max_f32_e32 %0, %1, %2":"=v"(r):"v"(a),"v"(b));return r;}
__device__ __forceinline__ float fadd_s(float a,float b){float r;asm("v_add_f32_e32 %0, %1, %2":"=v"(r):"v"(a),"v"(b));return r;}
__device__ __forceinline__ float fsub_s(float a,float b){float r;asm("v_sub_f32_e32 %0, %1, %2":"=v"(r):"v"(a),"v"(b));return r;}
typedef float f32x2_t __attribute__((ext_vector_type(2))); typedef __bf16 bf16x2_t __attribute__((ext_vector_type(2)));
__device__ __forceinline__ unsigned cvtpk_s(float lo,float hi){f32x2_t v={lo,hi};bf16x2_t b=__builtin_convertvector(v,bf16x2_t);return __builtin_bit_cast(unsigned,b);}
#define WAIT_BAR(N) asm volatile("s_waitcnt vmcnt(" #N ") lgkmcnt(0)\n\ts_barrier":::"memory")

__device__ __forceinline__ void qkt(f32x16&p0,f32x16&p1,const char*Kslot,const bf16x8*qr,const f32x16&negm,int r32,int hi){
  const char*kb=Kslot+hi*1024+r32*16;
  #pragma unroll
  for(int d0=0;d0<4;++d0){
    const bf16x8 b0=*reinterpret_cast<const bf16x8*>(kb+d0*2048);
    const bf16x8 b1=*reinterpret_cast<const bf16x8*>(kb+d0*2048+512);
    if(d0==0){p0=__builtin_amdgcn_mfma_f32_32x32x16_bf16(b0,qr[0],negm,0,0,0);p1=__builtin_amdgcn_mfma_f32_32x32x16_bf16(b1,qr[0],negm,0,0,0);}
    else{p0=__builtin_amdgcn_mfma_f32_32x32x16_bf16(b0,qr[d0],p0,0,0,0);p1=__builtin_amdgcn_mfma_f32_32x32x16_bf16(b1,qr[d0],p1,0,0,0);}}
}
typedef __attribute__((address_space(3))) const char* lds_cptr;
typedef short v4i16_t __attribute__((ext_vector_type(4)));
__device__ __forceinline__ void kload8(bf16x8*kf,lds_cptr kp){
  kf[0]=*(const __attribute__((address_space(3))) bf16x8*)(kp);      kf[1]=*(const __attribute__((address_space(3))) bf16x8*)(kp+512);
  kf[2]=*(const __attribute__((address_space(3))) bf16x8*)(kp+2048); kf[3]=*(const __attribute__((address_space(3))) bf16x8*)(kp+2560);
  kf[4]=*(const __attribute__((address_space(3))) bf16x8*)(kp+4096); kf[5]=*(const __attribute__((address_space(3))) bf16x8*)(kp+4608);
  kf[6]=*(const __attribute__((address_space(3))) bf16x8*)(kp+6144); kf[7]=*(const __attribute__((address_space(3))) bf16x8*)(kp+6656);
}
__device__ __forceinline__ void kload2(bf16x8*kf,lds_cptr kp,int j){ kf[2*j]=*(const __attribute__((address_space(3))) bf16x8*)(kp+j*2048); kf[2*j+1]=*(const __attribute__((address_space(3))) bf16x8*)(kp+j*2048+512); }
__device__ __forceinline__ s16x4 vtr(lds_cptr p){ return __builtin_bit_cast(s16x4,__builtin_amdgcn_ds_read_tr16_b64_v4i16((__attribute__((address_space(3))) v4i16_t*)p)); }
__device__ __forceinline__ float rowmax(const f32x16&p0,const f32x16&p1){
  float a=max3f(p0[0],p0[1],p1[0]),b=max3f(p0[2],p0[3],p1[1]);a=max3f(a,p1[2],p1[3]);
  #pragma unroll
  for(int r=4;r<16;r+=4){a=max3f(a,p0[r],p0[r+1]);b=max3f(b,p0[r+2],p0[r+3]);a=max3f(a,p1[r],p1[r+1]);b=max3f(b,p1[r+2],p1[r+3]);}
  const float m=max2f(a,b);
  auto rr=__builtin_amdgcn_permlane32_swap(__float_as_uint(m),__float_as_uint(m),false,false);
  return max2f(__uint_as_float(rr[0]),__uint_as_float(rr[1]));
}
__device__ __forceinline__ void pv(f32x16*o,int vb,bf16x8 pa0,bf16x8 pa1,bf16x8 pa2,bf16x8 pa3){
  #pragma unroll
  for(int d0=0;d0<2;++d0){s16x4 lo[4],hi[4];
    #pragma unroll
    for(int ks=0;ks<4;++ks){
      asm volatile("ds_read_b64_tr_b16 %0,%1 offset:%c2":"=&v"(lo[ks]):"v"(vb),"i"(d0*4096+ks*1024):"memory");
      asm volatile("ds_read_b64_tr_b16 %0,%1 offset:%c2":"=&v"(hi[ks]):"v"(vb),"i"(d0*4096+ks*1024+512):"memory");}
    asm volatile("s_waitcnt lgkmcnt(0)":::"memory");SBAR();
    #define PK(k) (bf16x8){lo[k][0],lo[k][1],lo[k][2],lo[k][3],hi[k][0],hi[k][1],hi[k][2],hi[k][3]}
    o[d0]=__builtin_amdgcn_mfma_f32_32x32x16_bf16(pa0,PK(0),o[d0],0,0,0);
    o[d0]=__builtin_amdgcn_mfma_f32_32x32x16_bf16(pa1,PK(1),o[d0],0,0,0);
    o[d0]=__builtin_amdgcn_mfma_f32_32x32x16_bf16(pa2,PK(2),o[d0],0,0,0);
    o[d0]=__builtin_amdgcn_mfma_f32_32x32x16_bf16(pa3,PK(3),o[d0],0,0,0);
    #undef PK
  }
}

#ifndef ATTN_STORE16
#define ATTN_STORE16(p,v) (*(u32x4*)(p)=(v))
#endif
template<int THRL,int QP,int KP,int OP> __device__ __forceinline__ void attn_unit(const bf16*Qw,const bf16*__restrict__ Kh,const bf16*__restrict__ Vh,bf16*Ow,const int NT,char*shm,const int tid){
  const int lane=tid&63,r32=lane&31,hi=lane>>5; const int wid=__builtin_amdgcn_readfirstlane(tid>>6);
  const unsigned lds0=(unsigned)(uintptr_t)shm;
  float*wsf=(float*)(shm+LDS_WS)+wid*64;
  const bf16*ksrc=Kh+(long)lane*KP+wid*8;
  const bf16*vsrc=Vh+(long)(16*(wid&3)+(lane>>2))*KP+(wid>>2)*32+(lane&3)*8;
  const unsigned kdst=lds0+LDS_K+wid*1024, vdst=lds0+LDS_V+wid*1024;
  #define DMA_K(t,slot) glds16(ksrc+(long)(t)*KVBLK*KP,(unsigned)__builtin_amdgcn_readfirstlane(kdst+(slot)))
  #define DMA_V(t,slot) glds16(vsrc+(long)(t)*KVBLK*KP,(unsigned)__builtin_amdgcn_readfirstlane(vdst+(slot)))
  const int vb0=(int)(lds0+LDS_V)+((lane>>4)&1)*32+(lane&3)*8+(4*hi+((lane&15)>>2))*64;
  const char*Kbase=shm+LDS_K; bf16x8 kf[8];
  const lds_cptr shm3=(lds_cptr)shm; const lds_cptr kp0=shm3+LDS_K+hi*1024+r32*16; const lds_cptr vp0=shm3+LDS_V+((lane>>4)&1)*32+(lane&3)*8+(4*hi+((lane&15)>>2))*64;
  DMA_K(0,0);DMA_V(0,0);DMA_K(1,SLOTB);
  bf16x8 qr[4];
  #pragma unroll
  for(int d0=0;d0<4;++d0)qr[d0]=*reinterpret_cast<const bf16x8*>(&Qw[(long)r32*QP+d0*16+hi*8]);
  float mhat=0.f,l_reg=0.f;f32x16 o[2];o[0]=f32x16{};o[1]=f32x16{};f32x16 negm=f32x16{};asm volatile("":"+v"(negm));
  #define CMASK(P0,P1,t) do{}while(0)
  bool resc=false;
  #define START(P0,P1) do{ const float rm=rowmax(P0,P1); resc=false; \
    { const float dl=rm; mhat=fadd_s(mhat,dl); \
      _Pragma("unroll") for(int r=0;r<16;++r){P0[r]=fsub_s(P0[r],dl);P1[r]=fsub_s(P1[r],dl);} \
      _Pragma("unroll") for(int r=0;r<16;++r)negm[r]=-mhat; asm volatile("":"+v"(negm)); } \
    _Pragma("unroll") for(int r=0;r<16;++r)P0[r]=__builtin_amdgcn_exp2f(P0[r]); }while(0)
  #define RESC() do{ if(resc){ asm volatile("s_waitcnt lgkmcnt(0)":::"memory"); \
      _Pragma("unroll") for(int d_=0;d_<2;++d_) _Pragma("unroll") for(int r=0;r<16;++r)o[d_][r]*=wsf[crow(r,hi)]; } }while(0)
  f32x16 pA0,pA1,pB0,pB1;
  int sl_prev=0,sl_cur=0,sl_next=SLOTB;
  #define ROT() do{sl_prev=sl_cur;sl_cur=sl_next;sl_next=(sl_next==(NSLOT-1)*SLOTB)?0:sl_next+SLOTB;}while(0)
  DMA_K(2,2*SLOTB);
  WAIT_BAR(3);
  qkt(pA0,pA1,Kbase,qr,negm,r32,hi);asm volatile("s_nop 15\n\ts_nop 7":"+v"(pA0),"+v"(pA1));CMASK(pA0,pA1,0);
  START(pA0,pA1);
  _Pragma("unroll") for(int r=0;r<16;++r)pA1[r]=__builtin_amdgcn_exp2f(pA1[r]);
  WAIT_BAR(0);
  DMA_K(3,0);DMA_V(1,SLOTB);
  ROT();
  kload8(kf,kp0+sl_cur);
  WAIT_BAR(2);
  s16x4 vlo[8],vhi[8]; u32x4 pw0,pw1,pw2,pw3;
  #define PKW(P,B) cvtpk_s(P[B],P[B+1])
  #define PAF(k) __builtin_bit_cast(bf16x8,pw##k)
  #define VFR(i) (bf16x8){vlo[i][0],vlo[i][1],vlo[i][2],vlo[i][3],vhi[i][0],vhi[i][1],vhi[i][2],vhi[i][3]}
  #define PIN(x) asm volatile("":"+v"(x))
  #define MX3(a,b,c) __builtin_fmaxf(__builtin_fmaxf((a),(b)),(c))
  #define GAPA(MF,A0,A1,A2,A3,W0,W1,PW) do{ MF; sacc+=A0; sacc+=A1; sacc+=A2; sacc+=A3; PIN(sacc); W0; W1; PIN(PW); SBAR(); }while(0)
  #define EX(v) __builtin_amdgcn_exp2f(v)
  #define GAPB(MF,X,B) do{ MF; X[B]=EX(X[B]); X[B+1]=EX(X[B+1]); X[B+2]=EX(X[B+2]); X[B+3]=EX(X[B+3]); PIN(X); SBAR(); }while(0)
  #define VRD(i) do{ vlo[i]=vtr(vp_+(((i)>>2)*4096+((i)&3)*1024)); vhi[i]=vtr(vp_+(((i)>>2)*4096+((i)&3)*1024+512)); }while(0)
  #define KRD(G,j) do{ if(G){ kload2(kf,kp0+sl_next,j); SBAR(); } }while(0)
  #define STEP(C0,C1,P0,P1,t,GK,GV,GL) do{ SBAR(); \
    const lds_cptr vp_=vp0+sl_prev; \
    VRD(0); SBAR(); float sacc=(P0[0]+P0[1]); \
    GAPA(C0=__builtin_amdgcn_mfma_f32_32x32x16_bf16(kf[0],qr[0],negm,0,0,0), P0[2],P0[3],P0[4],P0[5],     pw0[0]=PKW(P0,0), pw0[1]=PKW(P0,2), pw0); \
    VRD(4); SBAR(); GAPA(C1=__builtin_amdgcn_mfma_f32_32x32x16_bf16(kf[1],qr[0],negm,0,0,0), P0[6],P0[7],P0[8],P0[9],     pw0[2]=PKW(P0,4), pw0[3]=PKW(P0,6), pw0); \
    VRD(1); SBAR(); GAPA(C0=__builtin_amdgcn_mfma_f32_32x32x16_bf16(kf[2],qr[1],C0,0,0,0),   P0[10],P0[11],P0[12],P0[13], pw1[0]=PKW(P0,8), pw1[1]=PKW(P0,10), pw1); \
    VRD(5); SBAR(); GAPA(C1=__builtin_amdgcn_mfma_f32_32x32x16_bf16(kf[3],qr[1],C1,0,0,0),   P0[14],P0[15],P1[0],P1[1],   pw1[2]=PKW(P0,12),pw1[3]=PKW(P0,14), pw1); \
    VRD(2); SBAR(); GAPA(C0=__builtin_amdgcn_mfma_f32_32x32x16_bf16(kf[4],qr[2],C0,0,0,0),   P1[2],P1[3],P1[4],P1[5],     pw2[0]=PKW(P1,0), pw2[1]=PKW(P1,2), pw2); \
    VRD(6); SBAR(); GAPA(C1=__builtin_amdgcn_mfma_f32_32x32x16_bf16(kf[5],qr[2],C1,0,0,0),   P1[6],P1[7],P1[8],P1[9],     pw2[2]=PKW(P1,4), pw2[3]=PKW(P1,6), pw2); \
    VRD(3); SBAR(); GAPA(C0=__builtin_amdgcn_mfma_f32_32x32x16_bf16(kf[6],qr[3],C0,0,0,0),   P1[10],P1[11],P1[12],P1[13], pw3[0]=PKW(P1,8), pw3[1]=PKW(P1,10), pw3); \
    VRD(7); SBAR(); GAPA(C1=__builtin_amdgcn_mfma_f32_32x32x16_bf16(kf[7],qr[3],C1,0,0,0),   P1[14],P1[15],0.f,0.f,       pw3[2]=PKW(P1,12),pw3[3]=PKW(P1,14), pw3); \
    l_reg+=sacc; \
    if(GK){DMA_K((t)+3,sl_cur);} if(GV){DMA_V((t)+1,sl_next);} \
    CMASK(C0,C1,t); \
    { float a=MX3(C0[0],C0[1],C1[0]),b=MX3(C0[2],C0[3],C1[1]); a=MX3(a,C1[2],C1[3]); \
      _Pragma("unroll") for(int r=4;r<16;r+=4){a=MX3(a,C0[r],C0[r+1]);b=MX3(b,C0[r+2],C0[r+3]);a=MX3(a,C1[r],C1[r+1]);b=MX3(b,C1[r+2],C1[r+3]);} \
      float rm=__builtin_fmaxf(a,b); { auto rr=__builtin_amdgcn_permlane32_swap(__float_as_uint(rm),__float_as_uint(rm),false,false); rm=__builtin_fmaxf(__uint_as_float(rr[0]),__uint_as_float(rr[1])); } \
      resc=false; \
      if(__builtin_expect(__any(rm>(float)THRL),0)){ const float dl=__builtin_fmaxf(rm,0.f); mhat+=dl; \
        _Pragma("unroll") for(int r=0;r<16;++r){C0[r]-=dl;C1[r]-=dl;} \
        _Pragma("unroll") for(int r=0;r<16;++r)negm[r]=-mhat; asm volatile("":"+v"(negm)); \
        const float f=__builtin_amdgcn_exp2f(-dl); l_reg*=f; if(hi==0)wsf[r32]=f; resc=true; } } \
    SBAR(); \
    GAPB(o[0]=__builtin_amdgcn_mfma_f32_32x32x16_bf16(PAF(0),VFR(0),o[0],0,0,0), C0,0); \
    GAPB(o[1]=__builtin_amdgcn_mfma_f32_32x32x16_bf16(PAF(0),VFR(4),o[1],0,0,0), C0,4); \
    KRD(GL,0); GAPB(o[0]=__builtin_amdgcn_mfma_f32_32x32x16_bf16(PAF(1),VFR(1),o[0],0,0,0), C0,8); \
    KRD(GL,1); GAPB(o[1]=__builtin_amdgcn_mfma_f32_32x32x16_bf16(PAF(1),VFR(5),o[1],0,0,0), C0,12); \
    KRD(GL,2); GAPB(o[0]=__builtin_amdgcn_mfma_f32_32x32x16_bf16(PAF(2),VFR(2),o[0],0,0,0), C1,0); \
    KRD(GL,3); GAPB(o[1]=__builtin_amdgcn_mfma_f32_32x32x16_bf16(PAF(2),VFR(6),o[1],0,0,0), C1,4); \
    GAPB(o[0]=__builtin_amdgcn_mfma_f32_32x32x16_bf16(PAF(3),VFR(3),o[0],0,0,0), C1,8); \
    GAPB(o[1]=__builtin_amdgcn_mfma_f32_32x32x16_bf16(PAF(3),VFR(7),o[1],0,0,0), C1,12); \
    }while(0)
  int t=1;
  #undef CMASK
  #define CMASK(P0,P1,t) do{}while(0)
  for(;t+5<NT;t+=2){
    STEP(pB0,pB1,pA0,pA1,t,true,true,true);     WAIT_BAR(2); RESC(); ROT();
    STEP(pA0,pA1,pB0,pB1,t+1,true,true,true);   WAIT_BAR(2); RESC(); ROT();
  }
  #undef CMASK
  #define CMASK(P0,P1,t) do{}while(0)
  #define ENDW(tt) do{ if((tt)+3<NT){WAIT_BAR(2);} else if((tt)+2<NT){WAIT_BAR(1);} else {WAIT_BAR(0);} }while(0)
  for(;t+1<NT;t+=2){
    STEP(pB0,pB1,pA0,pA1,t,(t+3<NT),(t+1<NT),(t+1<NT));       ENDW(t);   RESC(); ROT();
    STEP(pA0,pA1,pB0,pB1,t+1,(t+4<NT),(t+2<NT),(t+2<NT));     ENDW(t+1); RESC(); ROT();
  }
  STEP(pB0,pB1,pA0,pA1,NT-1,false,false,false); RESC();
  { float sacc=pB0[0]+pB0[1]; _Pragma("unroll") for(int r=2;r<16;++r)sacc+=pB0[r]; _Pragma("unroll") for(int r=0;r<16;++r)sacc+=pB1[r]; l_reg+=sacc;
    pw0=(u32x4){PKW(pB0,0),PKW(pB0,2),PKW(pB0,4),PKW(pB0,6)};pw1=(u32x4){PKW(pB0,8),PKW(pB0,10),PKW(pB0,12),PKW(pB0,14)};pw2=(u32x4){PKW(pB1,0),PKW(pB1,2),PKW(pB1,4),PKW(pB1,6)};pw3=(u32x4){PKW(pB1,8),PKW(pB1,10),PKW(pB1,12),PKW(pB1,14)};
    SBAR(); pv(o,vb0+sl_cur,PAF(0),PAF(1),PAF(2),PAF(3)); }
  #undef PKW
  #undef PAF
  #undef VFR
  #undef PIN
  #undef MX3
  #undef GAPA
  #undef GAPB
  #undef EX
  #undef VRD
  #undef KRD
  #undef STEP
  #undef ENDW
  {auto rr=__builtin_amdgcn_permlane32_swap(__float_as_uint(l_reg),__float_as_uint(l_reg),false,false);l_reg=__uint_as_float(rr[0])+__uint_as_float(rr[1]);}
  if(hi==0)wsf[32+r32]=l_reg;asm volatile("s_waitcnt lgkmcnt(0)":::"memory");
  float rli[16];
  #pragma unroll
  for(int r=0;r<16;++r)rli[r]=__builtin_amdgcn_rcpf(wsf[32+crow(r,hi)]);
  { bf16*stg=(bf16*)(shm+LDS_OST)+wid*2048;
    #pragma unroll
    for(int r=0;r<16;++r){const int orow=crow(r,hi);
      #pragma unroll
      for(int d0=0;d0<2;++d0)stg[orow*64+d0*32+r32]=(bf16)f2bf_dev(o[d0][r]*rli[r]);}
    asm volatile("s_waitcnt lgkmcnt(0)":::"memory");
    #pragma unroll
    for(int i=0;i<4;++i){const int row=i*8+(lane>>3),ch=lane&7; const u32x4 v=*(const u32x4*)(stg+row*64+ch*8); ATTN_STORE16(Ow+(long)row*OP+ch*8,v);} }
  asm volatile("s_waitcnt lgkmcnt(0)\n\ts_barrier":::"memory");
  #undef DMA_K
  #undef DMA_V
  #undef CMASK
  #undef START
  #undef RESC
  #undef ROT
}
constexpr int ATTN_LDS_BYTES=LDS_BYTES;
}

constexpr int SEQ = 16384, BATCH = 2, MTOK = BATCH * SEQ, DM = 1024, DEPTH = 4;
constexpr int NQH = 12, NKVH = 3, NMH = 4, NMEM = 256;
constexpr int QW = 768, KVW = 192, QMW = 256, INW = 1408, INWP = 1536, DFF = 2816, GUW = 5632;
constexpr float EPS = 1e-6f;
constexpr float QSCALE = 0.125f * 1.4426950408889634f;

typedef unsigned short bf16_t;
typedef short bf16x8 __attribute__((ext_vector_type(8)));
typedef float f32x4 __attribute__((ext_vector_type(4)));
typedef float f32x16 __attribute__((ext_vector_type(16)));
typedef unsigned u32x4 __attribute__((ext_vector_type(4)));
typedef unsigned u32x2 __attribute__((ext_vector_type(2)));
#define LAS __attribute__((address_space(3)))

constexpr size_t MiB = 1u << 20;
constexpr size_t WS_TAB = 0;
constexpr size_t WS_MEMN = 2 * MiB;
constexpr size_t WS_KVM = 3 * MiB;
constexpr size_t WS_LSE = 5 * MiB;
constexpr size_t WS_W = 8 * MiB;
constexpr size_t W_LAYER = 23 * MiB, WO_IN = 0, WO_O = 3 * MiB, WO_GU = 5 * MiB, WO_D = 16 * MiB;
constexpr size_t WS_WKV = WS_W + 4 * W_LAYER;
constexpr size_t WS_HB = 104 * MiB;
constexpr size_t WS_OB = 168 * MiB;
constexpr size_t WS_R1 = 232 * MiB;
constexpr size_t WS_Q = WS_R1, WS_K = WS_Q + 48 * MiB, WS_V = WS_K + 12 * MiB, WS_QM = WS_V + 12 * MiB, WS_CTX = WS_QM + 16 * MiB;
constexpr size_t WS_END = WS_R1 + 176 * MiB;

struct Params {
    const float* x; const float* mem; const float* mem_g; const float* w_in; const float* w_kv; const float* w_o;
    const float* g_mix_pre; const float* g_mix_post; const float* sink; const float* qk_g;
    const float* w_gu; const float* w_d; const float* g_ffn_pre; const float* g_ffn_post;
    float* out; unsigned char* ws;
    float invp[8]; float inva[16];
    int ph_lo, ph_hi;
};

__device__ __forceinline__ unsigned f2bf(float f) { unsigned u = __builtin_bit_cast(unsigned, f); return (u + 0x7fffu + ((u >> 16) & 1u)) >> 16; }
__device__ __forceinline__ unsigned pk2(float lo, float hi) { return pg8::cvt_pk_bf16(lo, hi); }
__device__ __forceinline__ float bflo(unsigned w) { return __builtin_bit_cast(float, w << 16); }
__device__ __forceinline__ float bfhi(unsigned w) { return __builtin_bit_cast(float, w & 0xffff0000u); }
__device__ __forceinline__ float wave_sum(float v) {
#pragma unroll
    for (int o = 1; o < 64; o <<= 1) v += __shfl_xor(v, o);
    return v;
}

struct EpiPlain {
    static constexpr bool PERM = true, AFTER_DRAIN = false;
    bf16_t* O; int ldc;
    __device__ __forceinline__ void operator()(const f32x4 (&acc)[2][2][4][2], const pg8::Unit& u, int wr, int wc, int fr, int fq) const {
        const int row0 = u.pm * 256 + wr * 64 + fr, col0 = u.pn * 256 + wc * 32 + 8 * fq;
#pragma unroll
        for (int ai = 0; ai < 2; ++ai)
#pragma unroll
            for (int m = 0; m < 4; ++m) { bf16_t* rowp = O + (size_t)(row0 + ai * 128 + m * 16) * ldc + col0;
#pragma unroll
                for (int bj = 0; bj < 2; ++bj) { const f32x4 v0 = acc[ai][bj][m][0], v1 = acc[ai][bj][m][1];
                    u32x4 w; w.x = pk2(v0[0], v0[1]); w.y = pk2(v0[2], v0[3]); w.z = pk2(v1[0], v1[1]); w.w = pk2(v1[2], v1[3]);
                    *(u32x4*)(rowp + bj * 128) = w; } }
    }
};
struct EpiSwiGLU {
    static constexpr bool PERM = true, AFTER_DRAIN = false;
    bf16_t* O; int ldc;
    __device__ __forceinline__ void operator()(const f32x4 (&acc)[2][2][4][2], const pg8::Unit& u, int wr, int wc, int fr, int fq) const {
        const int row0 = u.pm * 256 + wr * 64 + fr, col0 = u.pn * 128 + wc * 32 + 8 * fq;
#pragma unroll
        for (int ai = 0; ai < 2; ++ai)
#pragma unroll
            for (int m = 0; m < 4; ++m) { bf16_t* rowp = O + (size_t)(row0 + ai * 128 + m * 16) * ldc + col0;
                float r[8];
#pragma unroll
                for (int n = 0; n < 2; ++n)
#pragma unroll
                    for (int j = 0; j < 4; ++j) { const float g = acc[ai][0][m][n][j], up = acc[ai][1][m][n][j];
                        const float s = __builtin_amdgcn_rcpf(1.0f + __builtin_amdgcn_exp2f(-1.4426950408889634f * g));
                        r[n * 4 + j] = g * s * up; }
                u32x4 w; w.x = pk2(r[0], r[1]); w.y = pk2(r[2], r[3]); w.z = pk2(r[4], r[5]); w.w = pk2(r[6], r[7]);
                *(u32x4*)rowp = w; }
    }
};
struct EpiIn {
    static constexpr bool PERM = true, AFTER_DRAIN = false;
    bf16_t *Q, *K, *V, *QM; int kind;
    const float *cosp, *sinp, *cosa, *sina; const float* qkg;
    __device__ __forceinline__ void operator()(const f32x4 (&acc)[2][2][4][2], const pg8::Unit& u, int wr, int wc, int fr, int fq) const {
        const int vh = 4 * u.pn + wc; if (vh >= 22) return;
        const int row0 = u.pm * 256 + wr * 64 + fr;
        const bool isq = vh < 12, isk = vh >= 12 && vh < 15, isv = vh >= 15 && vh < 18;
        bf16_t* base; int ld;
        if (isq) { base = Q + vh * 64; ld = QW; } else if (isk) { base = K + (vh - 12) * 64; ld = KVW; } else if (isv) { base = V + (vh - 15) * 64; ld = KVW; } else { base = QM + (vh - 18) * 64; ld = QMW; }
        const float osc = (isq || (!isk && !isv)) ? QSCALE : 1.0f;
#pragma unroll
        for (int ai = 0; ai < 2; ++ai)
#pragma unroll
            for (int m = 0; m < 4; ++m) {
                const int row = row0 + ai * 128 + m * 16, t = row & (SEQ - 1);
                float v[2][8];
#pragma unroll
                for (int bj = 0; bj < 2; ++bj)
#pragma unroll
                    for (int n = 0; n < 2; ++n)
#pragma unroll
                        for (int j = 0; j < 4; ++j) v[bj][n * 4 + j] = acc[ai][bj][m][n][j];
                if (isq || isk) {
                    if (kind == 1) {
                        float ss = 0.f;
#pragma unroll
                        for (int bj = 0; bj < 2; ++bj)
#pragma unroll
                            for (int e = 0; e < 8; ++e) ss += v[bj][e] * v[bj][e];
                        ss += __shfl_xor(ss, 16); ss += __shfl_xor(ss, 32);
                        const float rs = 1.0f / sqrtf(ss * (1.0f / 64.0f) + EPS);
                        const float* gp = qkg + (isk ? 64 : 0) + 8 * fq;
#pragma unroll
                        for (int bj = 0; bj < 2; ++bj) { const f32x4 g0 = *(const f32x4*)(gp + 32 * bj), g1 = *(const f32x4*)(gp + 32 * bj + 4);
#pragma unroll
                            for (int e = 0; e < 4; ++e) { v[bj][e] *= rs * g0[e]; v[bj][4 + e] *= rs * g1[e]; } }
#pragma unroll
                        for (int bj = 0; bj < 2; ++bj) {
                            const int ti = (bj == 0 ? (t >> 6) : (t & 63)) * 16 + 8 * (fq & 1);
                            const f32x4 c0 = *(const f32x4*)(cosa + ti), c1 = *(const f32x4*)(cosa + ti + 4), s0 = *(const f32x4*)(sina + ti), s1 = *(const f32x4*)(sina + ti + 4);
#pragma unroll
                            for (int e = 0; e < 8; ++e) { const float pr = __shfl_xor(v[bj][e], 32); const float c = e < 4 ? c0[e & 3] : c1[e & 3], s = e < 4 ? s0[e & 3] : s1[e & 3];
                                v[bj][e] = v[bj][e] * c + (fq < 2 ? -pr : pr) * s; }
                        }
                    } else {
                        const f32x4 c0 = *(const f32x4*)(cosp + t * 8), c1 = *(const f32x4*)(cosp + t * 8 + 4), s0 = *(const f32x4*)(sinp + t * 8), s1 = *(const f32x4*)(sinp + t * 8 + 4);
#pragma unroll
                        for (int e = 0; e < 8; ++e) { const float pr = __shfl_xor(v[0][e], 16); const float c = e < 4 ? c0[e & 3] : c1[e & 3], s = e < 4 ? s0[e & 3] : s1[e & 3];
                            const float rv = v[0][e] * c + (fq == 0 ? -pr : pr) * s; v[0][e] = fq < 2 ? rv : v[0][e]; }
                    }
                }
                bf16_t* rowp = base + (size_t)row * ld + 8 * fq;
#pragma unroll
                for (int bj = 0; bj < 2; ++bj) { u32x4 w; w.x = pk2(v[bj][0] * osc, v[bj][1] * osc); w.y = pk2(v[bj][2] * osc, v[bj][3] * osc); w.z = pk2(v[bj][4] * osc, v[bj][5] * osc); w.w = pk2(v[bj][6] * osc, v[bj][7] * osc);
                    *(u32x4*)(rowp + 32 * bj) = w; }
            }
    }
};

__device__ __forceinline__ void transpose_item(const float* W, int K, int ldw, bf16_t* WT, int dst_row0, int src_col0, const float* gk, LAS float* scr, int kb, int lane) {
    const int k0 = 64 * kb;
#pragma unroll 8
    for (int i = 0; i < 32; ++i) { const int kk = 2 * i + (lane >> 5); float val = 0.f;
        if (src_col0 >= 0) { val = W[(size_t)(k0 + kk) * ldw + src_col0 + (lane & 31)]; if (gk) val *= gk[k0 + kk]; }
        scr[kk * 33 + (lane & 31)] = val; }
    asm volatile("s_waitcnt lgkmcnt(0)" ::: "memory");
    const int c = lane & 7;
#pragma unroll
    for (int j = 0; j < 4; ++j) { const int n = (lane >> 3) + 8 * j; const LAS float* s = scr + (8 * c) * 33 + n;
        u32x4 o; o.x = pk2(s[0 * 33], s[1 * 33]); o.y = pk2(s[2 * 33], s[3 * 33]); o.z = pk2(s[4 * 33], s[5 * 33]); o.w = pk2(s[6 * 33], s[7 * 33]);
        *(u32x4*)(WT + (size_t)(dst_row0 + n) * K + k0 + 8 * c) = o; }
    asm volatile("s_waitcnt lgkmcnt(0)" ::: "memory");
}
__device__ __forceinline__ void row_pass(const bf16_t* ob, const float* g, const float* xi, float* xo, bf16_t* hb, const float* g2, int lane) {
    f32x4 x[4];
#pragma unroll
    for (int j = 0; j < 4; ++j) x[j] = *(const f32x4*)(xi + 4 * lane + 256 * j);
    if (ob) {
        f32x4 o[4]; float ss = 0.f;
#pragma unroll
        for (int j = 0; j < 4; ++j) { const u32x2 w = *(const u32x2*)(ob + 4 * lane + 256 * j); o[j] = (f32x4){bflo(w.x), bfhi(w.x), bflo(w.y), bfhi(w.y)};
            ss += (o[j][0] * o[j][0] + o[j][1] * o[j][1]) + (o[j][2] * o[j][2] + o[j][3] * o[j][3]); }
        const float rs = 1.0f / sqrtf(wave_sum(ss) * (1.0f / DM) + EPS);
#pragma unroll
        for (int j = 0; j < 4; ++j) { const f32x4 gv = *(const f32x4*)(g + 4 * lane + 256 * j); x[j] = x[j] + o[j] * rs * gv; }
#pragma unroll
        for (int j = 0; j < 4; ++j) *(f32x4*)(xo + 4 * lane + 256 * j) = x[j];
    }
    if (hb) {
        float ss = 0.f;
#pragma unroll
        for (int j = 0; j < 4; ++j) ss += (x[j][0] * x[j][0] + x[j][1] * x[j][1]) + (x[j][2] * x[j][2] + x[j][3] * x[j][3]);
        const float rs = 1.0f / sqrtf(wave_sum(ss) * (1.0f / DM) + EPS);
#pragma unroll
        for (int j = 0; j < 4; ++j) { f32x4 y = x[j] * rs; if (g2) y = y * *(const f32x4*)(g2 + 4 * lane + 256 * j);
            u32x2 w; w.x = pk2(y[0], y[1]); w.y = pk2(y[2], y[3]); *(u32x2*)(hb + 4 * lane + 256 * j) = w; }
    }
}

constexpr int AT_PITCH = 72, AT_TILE_B = 64 * AT_PITCH * 2, AT_K = 0, AT_V = 2 * AT_TILE_B;
__device__ __forceinline__ int crow(int r, int hi) { return (r & 3) + 8 * (r >> 2) + 4 * hi; }
__device__ __forceinline__ void attn_unit(LAS unsigned char* lds, const bf16_t* Qp, int qpitch, long qrowbase, int qstride, int iq,
                                          const bf16_t* Kp, const bf16_t* Vp, int kpitch, long krowbase, int kstride,
                                          int t_lo, int t_hi, int R, int q0blk,
                                          bf16_t* Op, int opitch, float* lsep, float sink_l2, bool has_sink, const int tid) {
    const int lane = tid & 63, r32 = lane & 31, hi = lane >> 5, wid = __builtin_amdgcn_readfirstlane(tid >> 6);
    const long qrow = qrowbase + (long)iq * qstride;
    bf16x8 qr[4];
#pragma unroll
    for (int d0 = 0; d0 < 4; ++d0) qr[d0] = *(const bf16x8*)(Qp + qrow * qpitch + d0 * 16 + hi * 8);
    float mrun = -1e30f, lrun = 0.f; f32x16 o[2];
#pragma unroll
    for (int r = 0; r < 16; ++r) { o[0][r] = 0.f; o[1][r] = 0.f; }
    const int vpos = (lane & ~15) + 8 * ((lane >> 2) & 1) + (lane & 3) + 4 * ((lane >> 3) & 1);
    u32x4 kreg, vreg;
    { const long kr = krowbase + (long)(t_lo * 64 + lane) * kstride; kreg = *(const u32x4*)(Kp + kr * kpitch + wid * 8); vreg = *(const u32x4*)(Vp + kr * kpitch + wid * 8); }
    for (int t = t_lo; t < t_hi; ++t) {
        const int buf = (t - t_lo) & 1;
        LAS unsigned char* ks = lds + AT_K + buf * AT_TILE_B; LAS unsigned char* vt = lds + AT_V + buf * AT_TILE_B;
        *(LAS u32x4*)(ks + lane * (AT_PITCH * 2) + wid * 16) = kreg;
        { LAS bf16_t* vb = (LAS bf16_t*)vt + (wid * 8) * AT_PITCH + vpos;
          vb[0 * AT_PITCH] = (bf16_t)(vreg.x & 0xffff); vb[1 * AT_PITCH] = (bf16_t)(vreg.x >> 16); vb[2 * AT_PITCH] = (bf16_t)(vreg.y & 0xffff); vb[3 * AT_PITCH] = (bf16_t)(vreg.y >> 16);
          vb[4 * AT_PITCH] = (bf16_t)(vreg.z & 0xffff); vb[5 * AT_PITCH] = (bf16_t)(vreg.z >> 16); vb[6 * AT_PITCH] = (bf16_t)(vreg.w & 0xffff); vb[7 * AT_PITCH] = (bf16_t)(vreg.w >> 16); }
        __syncthreads();
        if (t + 1 < t_hi) { const long kr = krowbase + (long)((t + 1) * 64 + lane) * kstride; kreg = *(const u32x4*)(Kp + kr * kpitch + wid * 8); vreg = *(const u32x4*)(Vp + kr * kpitch + wid * 8); }
        f32x16 p0, p1;
#pragma unroll
        for (int r = 0; r < 16; ++r) { p0[r] = 0.f; p1[r] = 0.f; }
#pragma unroll
        for (int d0 = 0; d0 < 4; ++d0) {
            const bf16x8 b0 = *(const LAS bf16x8*)(ks + r32 * (AT_PITCH * 2) + d0 * 32 + hi * 16);
            const bf16x8 b1 = *(const LAS bf16x8*)(ks + (32 + r32) * (AT_PITCH * 2) + d0 * 32 + hi * 16);
            p0 = __builtin_amdgcn_mfma_f32_32x32x16_bf16(b0, qr[d0], p0, 0, 0, 0);
            p1 = __builtin_amdgcn_mfma_f32_32x32x16_bf16(b1, qr[d0], p1, 0, 0, 0);
        }
        { const int dmax1 = q0blk + 63 - 64 * t, dmax2 = 64 * t + 63 - q0blk;
          if (dmax1 > R || dmax2 > R) {
#pragma unroll
              for (int r = 0; r < 16; ++r) { const int kv = 64 * t + crow(r, hi); int d = kv - iq; d = d < 0 ? -d : d; if (d > R) p0[r] = -1e30f; int d2 = kv + 32 - iq; d2 = d2 < 0 ? -d2 : d2; if (d2 > R) p1[r] = -1e30f; }
          } }
        float mt = fmaxf(p0[0], p1[0]);
#pragma unroll
        for (int r = 1; r < 16; ++r) mt = fmaxf(mt, fmaxf(p0[r], p1[r]));
        mt = fmaxf(mt, __shfl_xor(mt, 32));
        const float mnew = fmaxf(mrun, mt), alpha = __builtin_amdgcn_exp2f(mrun - mnew); mrun = mnew;
        float sum = 0.f;
#pragma unroll
        for (int r = 0; r < 16; ++r) { p0[r] = __builtin_amdgcn_exp2f(p0[r] - mnew); p1[r] = __builtin_amdgcn_exp2f(p1[r] - mnew); sum += p0[r] + p1[r]; }
        lrun = lrun * alpha + sum;
#pragma unroll
        for (int r = 0; r < 16; ++r) { o[0][r] *= alpha; o[1][r] *= alpha; }
        u32x4 pw[4];
        pw[0] = (u32x4){pk2(p0[0], p0[1]), pk2(p0[2], p0[3]), pk2(p0[4], p0[5]), pk2(p0[6], p0[7])};
        pw[1] = (u32x4){pk2(p0[8], p0[9]), pk2(p0[10], p0[11]), pk2(p0[12], p0[13]), pk2(p0[14], p0[15])};
        pw[2] = (u32x4){pk2(p1[0], p1[1]), pk2(p1[2], p1[3]), pk2(p1[4], p1[5]), pk2(p1[6], p1[7])};
        pw[3] = (u32x4){pk2(p1[8], p1[9]), pk2(p1[10], p1[11]), pk2(p1[12], p1[13]), pk2(p1[14], p1[15])};
#pragma unroll
        for (int d0 = 0; d0 < 2; ++d0)
#pragma unroll
            for (int ksx = 0; ksx < 4; ++ksx) {
                const bf16x8 vf = *(const LAS bf16x8*)(vt + (32 * d0 + r32) * (AT_PITCH * 2) + ksx * 32 + hi * 16);
                o[d0] = __builtin_amdgcn_mfma_f32_32x32x16_bf16(vf, __builtin_bit_cast(bf16x8, pw[ksx]), o[d0], 0, 0, 0);
            }
    }
    lrun += __shfl_xor(lrun, 32);
    if (has_sink) lrun += __builtin_amdgcn_exp2f(sink_l2 - mrun);
    const float inv = 1.0f / lrun;
    bf16_t* orow = Op + qrow * opitch;
#pragma unroll
    for (int d0 = 0; d0 < 2; ++d0)
#pragma unroll
        for (int rq = 0; rq < 4; ++rq) { u32x2 w; w.x = pk2(o[d0][4 * rq] * inv, o[d0][4 * rq + 1] * inv); w.y = pk2(o[d0][4 * rq + 2] * inv, o[d0][4 * rq + 3] * inv);
            *(u32x2*)(orow + 32 * d0 + 8 * rq + 4 * hi) = w; }
    if (lsep && hi == 0) lsep[qrow * 12] = mrun + __builtin_log2f(lrun);
    __syncthreads();
}

constexpr int LDS_BYTES = 131072 + 1024;
constexpr int NPHASES = 1 + 4 * 7 + 1;
#ifndef PROBE_ATT_L
#define PROBE_ATT_L -1
#endif

__device__ __forceinline__ float lse_weight(const float* L, int head) {
    const int j = head & 3; const float a = L[j], b = L[4 + j], c = L[8 + j], mine = L[head];
    const float m = fmaxf(a, fmaxf(b, c));
    const float s = __builtin_amdgcn_exp2f(a - m) + __builtin_amdgcn_exp2f(b - m) + __builtin_amdgcn_exp2f(c - m);
    return __builtin_amdgcn_exp2f(mine - m) / s;
}

__global__ void __launch_bounds__(512, 2) fwd_megakernel(Params p) {
    extern __shared__ __attribute__((aligned(16))) unsigned char lds_raw[];
    LAS unsigned char* lds = (LAS unsigned char*)lds_raw;
    cg::grid_group grid = cg::this_grid();
    const int tid = threadIdx.x, wid = __builtin_amdgcn_readfirstlane(tid >> 6);
    const int G = gridDim.x, gw = blockIdx.x * 8 + wid, NGW = G * 8;
    unsigned char* ws = p.ws;
    float* cosp = (float*)(ws + WS_TAB); float* sinp = cosp + SEQ * 8; float* cosa = sinp + SEQ * 8; float* sina = cosa + 256 * 16;
    bf16_t* MEMN = (bf16_t*)(ws + WS_MEMN); bf16_t* KVM = (bf16_t*)(ws + WS_KVM); float* LSE = (float*)(ws + WS_LSE);
    bf16_t* WKV = (bf16_t*)(ws + WS_WKV); bf16_t* HB = (bf16_t*)(ws + WS_HB); bf16_t* OB = (bf16_t*)(ws + WS_OB);
    bf16_t* Qb = (bf16_t*)(ws + WS_Q); bf16_t* Kb = (bf16_t*)(ws + WS_K); bf16_t* Vb = (bf16_t*)(ws + WS_V); bf16_t* QMb = (bf16_t*)(ws + WS_QM);
    bf16_t* CTX = (bf16_t*)(ws + WS_CTX); bf16_t* ACT = (bf16_t*)(ws + WS_R1);
    int ph = 0;
#define PH_ON (ph >= p.ph_lo && ph < p.ph_hi)
#define LAUNDER int tl_ = tid; asm volatile("" : "+v"(tl_)); const int lane = tl_ & 63; (void)lane
#define PH_END do { if (PH_ON && ph + 1 < p.ph_hi) grid.sync(); ++ph; } while (0)

    if (PH_ON) { LAUNDER;
        LAS float* scr = (LAS float*)(lds + wid * 16384);
        constexpr int I_IN = 16 * 48, I_O = 16 * 32, I_GU = 16 * 176, I_D = 44 * 32, I_KV = 16 * 16, I_L = I_IN + I_O + I_GU + I_D + I_KV;
        for (int it = gw; it < DEPTH * I_L; it += NGW) {
            const int l = it / I_L; int r = it % I_L;
            bf16_t* wl = (bf16_t*)(ws + WS_W + (size_t)l * W_LAYER);
            if (r < I_IN) { const int kb = r / 48, nb = r % 48, R0 = 32 * nb, tile = R0 >> 8, c = R0 & 255, vh = 4 * tile + ((c >> 5) & 3), src = vh < 22 ? 64 * vh + 32 * (c >> 7) : -1;
                transpose_item(p.w_in + (size_t)l * DM * INW, DM, INW, (bf16_t*)((unsigned char*)wl + WO_IN), R0, src, p.g_mix_pre + l * DM, scr, kb, lane); continue; }
            r -= I_IN;
            if (r < I_O) { const int kb = r / 32, nb = r % 32;
                transpose_item(p.w_o + (size_t)l * DM * DM, DM, DM, (bf16_t*)((unsigned char*)wl + WO_O), 32 * nb, 32 * nb, nullptr, scr, kb, lane); continue; }
            r -= I_O;
            if (r < I_GU) { const int kb = r / 176, nb = r % 176, R0 = 32 * nb, tile = R0 >> 8, c = R0 & 255, src = ((c >> 7) ? DFF : 0) + 128 * tile + (c & 127);
                transpose_item(p.w_gu + (size_t)l * DM * GUW, DM, GUW, (bf16_t*)((unsigned char*)wl + WO_GU), R0, src, p.g_ffn_pre + l * DM, scr, kb, lane); continue; }
            r -= I_GU;
            if (r < I_D) { const int kb = r / 32, nb = r % 32;
                transpose_item(p.w_d + (size_t)l * DFF * DM, DFF, DM, (bf16_t*)((unsigned char*)wl + WO_D), 32 * nb, 32 * nb, nullptr, scr, kb, lane); continue; }
            r -= I_D;
            { const int kb = r / 16, nb = r % 16;
                transpose_item(p.w_kv + (size_t)l * DM * 512, DM, 512, WKV + (size_t)l * 512 * DM, 32 * nb, 32 * nb, nullptr, scr, kb, lane); }
        }
        for (int e = blockIdx.x * 512 + tid; e < SEQ * 8; e += G * 512) {
            { const int t = e >> 3, i = e & 7; const float ang = (float)t * p.invp[i]; cosp[e] = cosf(ang); sinp[e] = sinf(ang); }
            if (e < 256 * 16) { const int t = e >> 4, i = e & 15; const float ang = (float)t * p.inva[i]; cosa[e] = cosf(ang); sina[e] = sinf(ang); }
        }
        for (int m = gw; m < BATCH * NMEM; m += NGW) row_pass(nullptr, nullptr, p.mem + (size_t)m * DM, nullptr, MEMN + (size_t)m * DM, p.mem_g, lane);
        for (int m = gw; m < MTOK; m += NGW) row_pass(nullptr, nullptr, p.x + (size_t)m * DM, nullptr, HB + (size_t)m * DM, nullptr, lane);
    }
    PH_END;

    for (int l = 0; l < DEPTH; ++l) {
        const int kind = l % 3;
        unsigned char* wl = ws + WS_W + (size_t)l * W_LAYER;
        if (PH_ON) { LAUNDER;
            if (l == 0) { pg8::Gemm g{MEMN, WKV, BATCH * NMEM, DEPTH * 512, DM}; pg8::StaticOrder S; S.init(BATCH * NMEM, DEPTH * 512, G, (int)blockIdx.x);
                EpiPlain E{KVM, DEPTH * 512}; pg8::gemm_phase<EpiPlain, pg8::StaticOrder, false, true>(lds, g, S, E, tl_); }
            pg8::Gemm g{HB, (const bf16_t*)(wl + WO_IN), MTOK, INWP, DM}; pg8::StaticOrder S; S.init(MTOK, INWP, G, (int)blockIdx.x);
            EpiIn E{Qb, Kb, Vb, QMb, kind, cosp, sinp, cosa, sina, p.qk_g + (l / 3) * 128};
            pg8::gemm_phase<EpiIn, pg8::StaticOrder, true, true>(lds, g, S, E, tl_);
        }
        PH_END;
        if (PH_ON) { LAUNDER;
            const int r32 = lane & 31;
            for (int rep = 0; rep < (l == PROBE_ATT_L ? 2 : 1); ++rep) {
            if (rep) grid.sync();
            for (int u = blockIdx.x; u < 2048; u += G) {
                if (u < 1536 && kind == 1) {
                    const int b = u / 768, rem = u % 768, kvh = rem >> 8, qb = rem & 255, head = 4 * kvh + (wid & 3); const long row = (long)b * SEQ + 64 * qb + 32 * (wid >> 2);
                    attn_body::attn_unit<8, QW, KVW, DM>(Qb + row * QW + head * 64, Kb + (long)b * SEQ * KVW + kvh * 64, Vb + (long)b * SEQ * KVW + kvh * 64, CTX + row * DM + head * 64, 256, (char*)lds_raw, tl_);
                    continue;
                }
                if (false) {
                    const int v = u - 1536, b = v >> 8, h = (v >> 6) & 3, qb = v & 63; const long row = (long)b * SEQ + 256 * qb + 32 * wid;
                    const bf16_t* kp = KVM + (long)b * NMEM * (DEPTH * 512) + l * 512 + h * 64;
                    attn_body::attn_unit<8, QMW, DEPTH * 512, DM>(QMb + row * QMW + h * 64, kp, kp + 256, CTX + row * DM + QW + h * 64, 4, (char*)lds_raw, tl_);
                    continue;
                }
                const bf16_t *Qp, *Kp, *Vp; bf16_t* Op; float* lsep = nullptr; int qpitch, kpitch, stride = 1, iq, tl, th, R = 1 << 30, q0 = 0; long qrb, krb; float sk = 0.f; bool hs = false;
                if (u < 1536) {
                    const int b = u / 768, rem = u % 768, kvh = rem >> 8, w = rem & 255, j = wid & 3, half = wid >> 2, head = 4 * kvh + j;
                    Qp = Qb + head * 64; qpitch = QW; Kp = Kb + kvh * 64; Vp = Vb + kvh * 64; kpitch = KVW; Op = CTX + head * 64;
                    int qb = w; qrb = (long)b * SEQ; tl = 0; th = 256;
                    if (kind == 2) { const int dil = 1 << (2 * kvh), nblk = 256 / dil, res = w / nblk; qb = w % nblk; stride = dil; qrb += res;
                        tl = qb - 1 < 0 ? 0 : qb - 1; th = qb + 2 > nblk ? nblk : qb + 2; R = 64; lsep = LSE + head; }
                    else if (kind == 0) { tl = qb - 2 < 0 ? 0 : qb - 2; th = qb + 3 > 256 ? 256 : qb + 3; R = 128; sk = p.sink[(l / 3) * NQH + head] * 1.4426950408889634f; hs = true; }
                    krb = qrb; q0 = 64 * qb; iq = q0 + 32 * half + r32;
                } else {
                    const int v = u - 1536, b = v >> 8, h = (v >> 6) & 3, qb = v & 63;
                    Qp = QMb + h * 64; qpitch = QMW; Kp = KVM + l * 512 + h * 64; Vp = Kp + 256; kpitch = DEPTH * 512; Op = CTX + QW + h * 64;
                    qrb = (long)b * SEQ; krb = (long)b * NMEM; tl = 0; th = 4; iq = 256 * qb + 32 * wid + r32;
                }
                attn_unit(lds, Qp, qpitch, qrb, stride, iq, Kp, Vp, kpitch, krb, stride, tl, th, R, q0, Op, DM, lsep, sk, hs, tl_);
            }
            }
        }
        PH_END;
        if (kind == 2) {
            if (PH_ON) { LAUNDER;
                for (int m = gw; m < MTOK; m += NGW) { const float* L = LSE + (size_t)m * 12; bf16_t* rowp = CTX + (size_t)m * DM;
#pragma unroll
                    for (int cc = 0; cc < 2; ++cc) { const int c = lane + 64 * cc; if (c < 96) { const float wgt = lse_weight(L, c >> 3);
                        u32x4 v = *(u32x4*)(rowp + c * 8);
                        v.x = pk2(bflo(v.x) * wgt, bfhi(v.x) * wgt); v.y = pk2(bflo(v.y) * wgt, bfhi(v.y) * wgt); v.z = pk2(bflo(v.z) * wgt, bfhi(v.z) * wgt); v.w = pk2(bflo(v.w) * wgt, bfhi(v.w) * wgt);
                        *(u32x4*)(rowp + c * 8) = v; } } }
            }
            PH_END;
        }
        if (PH_ON) { LAUNDER; pg8::Gemm g{CTX, (const bf16_t*)(wl + WO_O), MTOK, DM, DM}; pg8::StaticOrder S; S.init(MTOK, DM, G, (int)blockIdx.x);
            EpiPlain E{OB, DM}; pg8::gemm_phase<EpiPlain, pg8::StaticOrder, true, true>(lds, g, S, E, tl_); }
        PH_END;
        if (PH_ON) { LAUNDER; const float* xi = l == 0 ? p.x : p.out;
            for (int m = gw; m < MTOK; m += NGW) row_pass(OB + (size_t)m * DM, p.g_mix_post + l * DM, xi + (size_t)m * DM, p.out + (size_t)m * DM, HB + (size_t)m * DM, nullptr, lane); }
        PH_END;
        if (PH_ON) { LAUNDER; pg8::Gemm g{HB, (const bf16_t*)(wl + WO_GU), MTOK, GUW, DM}; pg8::StaticOrder S; S.init(MTOK, GUW, G, (int)blockIdx.x);
            EpiSwiGLU E{ACT, DFF}; pg8::gemm_phase<EpiSwiGLU, pg8::StaticOrder, true, true>(lds, g, S, E, tl_); }
        PH_END;
        if (PH_ON) { LAUNDER; pg8::Gemm g{ACT, (const bf16_t*)(wl + WO_D), MTOK, DM, DFF}; pg8::StaticOrder S; S.init(MTOK, DM, G, (int)blockIdx.x);
            EpiPlain E{OB, DM}; pg8::gemm_phase<EpiPlain, pg8::StaticOrder, true, true>(lds, g, S, E, tl_); }
        PH_END;
        if (PH_ON) { LAUNDER; for (int m = gw; m < MTOK; m += NGW) row_pass(OB + (size_t)m * DM, p.g_ffn_post + l * DM, p.out + (size_t)m * DM, p.out + (size_t)m * DM, l + 1 < DEPTH ? HB + (size_t)m * DM : nullptr, nullptr, lane); }
        PH_END;
    }
#undef PH_ON
#undef PH_END
}

extern "C" void kernel_launch(void* const* d_in, const int* in_sizes, int n_in, void* d_out, int out_size, void* d_ws, size_t ws_size, hipStream_t stream) {
    static int grid = 0;
    if (grid == 0) {
        if (n_in != 14 || in_sizes[0] != MTOK * DM || out_size != MTOK * DM || ws_size < WS_END) { fprintf(stderr, "kernel_launch: unexpected shapes (n_in %d, in0 %d, out %d, ws %zu)\n", n_in, n_in > 0 ? in_sizes[0] : -1, out_size, ws_size); grid = -1; return; }
        int dev = 0, cus = 0, per_cu = 0;
        hipGetDevice(&dev); hipDeviceGetAttribute(&cus, hipDeviceAttributeMultiprocessorCount, dev);
        if (hipFuncSetAttribute((const void*)fwd_megakernel, hipFuncAttributeMaxDynamicSharedMemorySize, LDS_BYTES) != hipSuccess) { fprintf(stderr, "kernel_launch: hipFuncSetAttribute failed\n"); grid = -1; return; }
        hipOccupancyMaxActiveBlocksPerMultiprocessor(&per_cu, (const void*)fwd_megakernel, 512, LDS_BYTES);
        (void)hipGetLastError();
        if (per_cu < 1) fprintf(stderr, "kernel_launch: occupancy query says %d blocks/CU\n", per_cu);
        grid = cus;
    }
    if (grid < 0) return;
    Params p{};
    p.x = (const float*)d_in[0]; p.mem = (const float*)d_in[1]; p.mem_g = (const float*)d_in[2]; p.w_in = (const float*)d_in[3]; p.w_kv = (const float*)d_in[4]; p.w_o = (const float*)d_in[5];
    p.g_mix_pre = (const float*)d_in[6]; p.g_mix_post = (const float*)d_in[7]; p.sink = (const float*)d_in[8]; p.qk_g = (const float*)d_in[9];
    p.w_gu = (const float*)d_in[10]; p.w_d = (const float*)d_in[11]; p.g_ffn_pre = (const float*)d_in[12]; p.g_ffn_post = (const float*)d_in[13];
    p.out = (float*)d_out; p.ws = (unsigned char*)d_ws;
    for (int i = 0; i < 8; ++i) p.invp[i] = powf(500000.0f, -((float)(2 * i) / 16.0f));
    for (int i = 0; i < 16; ++i) p.inva[i] = powf(10000.0f, -((float)(2 * i) / 32.0f));
    p.ph_lo = 0; p.ph_hi = NPHASES;
    void* args[] = {&p};
    hipError_t e = hipLaunchCooperativeKernel((const void*)fwd_megakernel, dim3(grid), dim3(512), args, LDS_BYTES, stream);
    if (e != hipSuccess) fprintf(stderr, "cooperative launch failed: %s (grid %d)\n", hipGetErrorString(e), grid);
}
```

```cpp
#include <hip/hip_runtime.h>
#include <hip/hip_cooperative_groups.h>
#include <cstdio>
#include <cstdint>
#include <cmath>
namespace cg = cooperative_groups;
namespace pg8 {
#define PG8_LAS __attribute__((address_space(3)))
typedef unsigned short bf16_t;
typedef short bf16x8 __attribute__((ext_vector_type(8)));
typedef float f32x4 __attribute__((ext_vector_type(4)));
typedef unsigned u32x4 __attribute__((ext_vector_type(4)));
constexpr int BM = 256, BK = 64, HALF = 128, HTB = HALF * BK * 2  , STAGE_BYTES = 8 * HTB, NXCD = 8, WGM = 8;

__host__ __device__ __forceinline__ int lds_byte(int r, int c) { const int st = (r >> 4) * 2 + (c >> 5), rr = r & 15, cc = c & 31, ob = rr * 64 + cc * 2; return st * 1024 + (ob ^ (((ob >> 9) & 1) << 5)); }
__host__ __device__ __forceinline__ void stage_rc(int b, int& R, int& C) { const int st = b / 1024, sb = b % 1024, swz = sb ^ (((sb >> 9) & 1) << 5); R = (st >> 1) * 16 + swz / 64; C = (st & 1) * 32 + (swz % 64) / 2; }
__host__ __device__ __forceinline__ int perm32(int rho) { const int n = rho >> 4, i = rho & 15; return 8 * (i >> 2) + 4 * n + (i & 3); }

struct Unit { int pm, pn; };
struct Gemm { const bf16_t* A; const bf16_t* Bt; int M, N, K; };

struct StaticOrder {
    int nM, nN, nwg, G, c;
    __host__ __device__ void init(int M, int N, int G_, int c_) { nM = M / BM; nN = N / BM; nwg = nM * nN; G = G_; c = c_; }
    __host__ __device__ bool next(int i, Unit& u) const {
        const long L = (long)i * G + c; if (L >= nwg) return false;
        int wgid = (int)L; { const int q = nwg / NXCD, r = nwg % NXCD, xcd = wgid % NXCD, off = wgid / NXCD; wgid = (xcd < r ? xcd * (q + 1) : r * (q + 1) + (xcd - r) * q) + off; }
        const int nig = WGM * nN, gid = wgid / nig, fm = gid * WGM, gsz = (nM - fm) < WGM ? (nM - fm) : WGM;
        u.pm = fm + ((wgid % nig) % gsz); u.pn = (wgid % nig) / gsz; return true;
    }
    __device__ __forceinline__ void a_ready(const Unit&) const {}
    __device__ __forceinline__ void done(const Unit&) const {}
};

__device__ __forceinline__ unsigned cvt_pk_bf16(float lo, float hi) { unsigned r; asm volatile("v_cvt_pk_bf16_f32 %0, %1, %2" : "=v"(r) : "v"(lo), "v"(hi)); return r; }
template <class Epi, class Sched, bool ALIGN_EPI = false, bool SP2 = false>
__device__ __forceinline__ void gemm_phase(PG8_LAS unsigned char* lds, const Gemm g, const Sched& S, const Epi& E, const int tid) {
    const int wid = __builtin_amdgcn_readfirstlane(tid >> 6), lane = tid & 63, wr = wid >> 2, wc = wid & 3, fr = lane & 15, fq = lane >> 4;
    const int K = g.K, nt = K / BK;
    unsigned voffA[2], voffB[2];
#pragma unroll
    for (int i = 0; i < 2; ++i) { int R, C; stage_rc(tid * 16 + i * 8192, R, C); const int Rb = Epi::PERM ? ((R & ~31) + perm32(R & 31)) : R;
        voffA[i] = (unsigned)(R * K + C) * 2u; voffB[i] = (unsigned)(Rb * K + C) * 2u; }
    const size_t kstep = (size_t)(BK * 2);
    const size_t hstep = (size_t)HALF * K * 2;
    const size_t tstep = 2 * hstep;
    const unsigned ldsw = (unsigned)wid * 1024u;
    const int aoff = lds_byte(wr * 64 + fr, fq * 8), boff = lds_byte(wc * 32 + fr, fq * 8);
#define PG8_SA(b, h) (((b) * 2 + (h)) * HTB)
#define PG8_SB(b, h) ((4 + (b) * 2 + (h)) * HTB)
#define PG8_STAGE(bufoff, gbase, voff) do { _Pragma("unroll") for (int _i = 0; _i < 2; ++_i) \
        __builtin_amdgcn_global_load_lds((const unsigned*)((const char*)(gbase) + (voff)[_i]), (PG8_LAS unsigned*)(lds + (bufoff) + ldsw + _i * 8192), 16, 0, 0); } while (0)
#define PG8_LDA(dst, b, h) do { _Pragma("unroll") for (int m = 0; m < 4; ++m) _Pragma("unroll") for (int k = 0; k < 2; ++k) dst[m][k] = *(const PG8_LAS bf16x8*)(lds + PG8_SA(b, h) + aoff + m * 2048 + k * 1024); } while (0)
#define PG8_LDB(dst, b, h) do { _Pragma("unroll") for (int n = 0; n < 2; ++n) _Pragma("unroll") for (int k = 0; k < 2; ++k) dst[n][k] = *(const PG8_LAS bf16x8*)(lds + PG8_SB(b, h) + boff + n * 2048 + k * 1024); } while (0)
#define PG8_MMA(ai, bj, At, Bt) do { __builtin_amdgcn_s_setprio(1); _Pragma("unroll") for (int m = 0; m < 4; ++m) _Pragma("unroll") for (int n = 0; n < 2; ++n) _Pragma("unroll") for (int k = 0; k < 2; ++k) \
        acc[ai][bj][m][n] = __builtin_amdgcn_mfma_f32_16x16x32_bf16(Bt[n][k], At[m][k], acc[ai][bj][m][n], 0, 0, 0); __builtin_amdgcn_s_setprio(0); } while (0)
#define PG8_WAIT_V(n) asm volatile("s_waitcnt vmcnt(" #n ")" ::: "memory")
#define PG8_WAIT_L(n) asm volatile("s_waitcnt lgkmcnt(" #n ")" ::: "memory")
#define PG8_BAR __builtin_amdgcn_s_barrier()
#define PG8_SCHED __builtin_amdgcn_sched_barrier(0)
    Unit cur, nxt; int ui = 0;
    if (!S.next(0, cur)) return;
    f32x4 acc[2][2][4][2];
#pragma unroll
    for (int a = 0; a < 2; ++a)
#pragma unroll
        for (int b = 0; b < 2; ++b)
#pragma unroll
            for (int m = 0; m < 4; ++m)
#pragma unroll
                for (int n = 0; n < 2; ++n) acc[a][b][m][n] = (f32x4){0.f, 0.f, 0.f, 0.f};
    bf16x8 At[4][2], B0[2][2], B1[2][2];
    const char* cA = (const char*)g.A + (size_t)cur.pm * tstep; const char* cB = (const char*)g.Bt + (size_t)cur.pn * tstep;
    S.a_ready(cur);
    if constexpr (SP2) {
        PG8_STAGE(PG8_SB(0, 0), cB, voffB); PG8_STAGE(PG8_SB(0, 1), cB + hstep, voffB); PG8_STAGE(PG8_SA(0, 0), cA, voffA); PG8_STAGE(PG8_SA(0, 1), cA + hstep, voffA);
        if (wr == 1) PG8_BAR;
        PG8_WAIT_V(2); PG8_BAR;
        PG8_STAGE(PG8_SB(1, 0), cB + kstep, voffB); PG8_STAGE(PG8_SA(1, 0), cA + kstep, voffA); PG8_STAGE(PG8_SB(1, 1), cB + hstep + kstep, voffB);
        PG8_WAIT_V(6); PG8_BAR;
    } else {
        PG8_STAGE(PG8_SB(0, 0), cB, voffB); PG8_STAGE(PG8_SA(0, 0), cA, voffA); PG8_STAGE(PG8_SB(0, 1), cB + hstep, voffB); PG8_STAGE(PG8_SA(0, 1), cA + hstep, voffA);
        if (wr == 1) PG8_BAR;
        PG8_WAIT_V(4); PG8_BAR;
        PG8_STAGE(PG8_SB(1, 0), cB + kstep, voffB); PG8_STAGE(PG8_SA(1, 0), cA + kstep, voffA); PG8_STAGE(PG8_SB(1, 1), cB + hstep + kstep, voffB);
        PG8_WAIT_V(6); PG8_BAR;
    }
    for (;;) {
        const bool has_next = S.next(ui + 1, nxt);
        const char* nA = has_next ? (const char*)g.A + (size_t)nxt.pm * tstep : cA; const char* nB = has_next ? (const char*)g.Bt + (size_t)nxt.pn * tstep : cB;
        for (int t = 0; t < nt; t += 2) {
            const bool last = (t == nt - 2);
            const char* a1 = cA + (size_t)(t + 1) * kstep;
            const char* a2 = last ? nA : cA + (size_t)(t + 2) * kstep; const char* b2 = last ? nB : cB + (size_t)(t + 2) * kstep;
            const char* a3 = a2 + kstep; const char* b3 = b2 + kstep;
            if (last && has_next) S.a_ready(nxt);
            if constexpr (SP2) {
            PG8_LDB(B0, 0, 0); PG8_LDB(B1, 0, 1); PG8_SCHED; PG8_LDA(At, 0, 0); PG8_STAGE(PG8_SA(1, 1), a1 + hstep, voffA);
            PG8_WAIT_V(8); PG8_WAIT_L(0); PG8_BAR; PG8_MMA(0, 0, At, B0); PG8_MMA(0, 1, At, B1); PG8_BAR; PG8_SCHED;
            PG8_LDA(At, 0, 1); PG8_STAGE(PG8_SB(0, 0), b2, voffB); PG8_STAGE(PG8_SB(0, 1), b2 + hstep, voffB); PG8_STAGE(PG8_SA(0, 0), a2, voffA);
            PG8_WAIT_V(8); PG8_WAIT_L(0); PG8_BAR; PG8_MMA(1, 0, At, B0); PG8_MMA(1, 1, At, B1); PG8_BAR; PG8_SCHED;
            PG8_LDB(B0, 1, 0); PG8_LDB(B1, 1, 1); PG8_SCHED; PG8_LDA(At, 1, 0); PG8_STAGE(PG8_SA(0, 1), a2 + hstep, voffA);
            PG8_WAIT_V(8); PG8_WAIT_L(0); PG8_BAR; PG8_MMA(0, 0, At, B0); PG8_MMA(0, 1, At, B1); PG8_BAR; PG8_SCHED;
            PG8_LDA(At, 1, 1); PG8_STAGE(PG8_SB(1, 0), b3, voffB); PG8_STAGE(PG8_SB(1, 1), b3 + hstep, voffB); PG8_STAGE(PG8_SA(1, 0), a3, voffA);
            PG8_WAIT_V(8); PG8_WAIT_L(0); PG8_BAR; PG8_MMA(1, 0, At, B0); PG8_MMA(1, 1, At, B1); PG8_BAR; PG8_SCHED;
            } else {
            PG8_LDB(B0, 0, 0); PG8_SCHED; PG8_LDA(At, 0, 0); PG8_STAGE(PG8_SA(1, 1), a1 + hstep, voffA);
            PG8_WAIT_L(8); PG8_BAR; PG8_WAIT_L(0); PG8_MMA(0, 0, At, B0); PG8_BAR; PG8_SCHED;
            PG8_LDB(B1, 0, 1); PG8_STAGE(PG8_SB(0, 0), b2, voffB);
            PG8_BAR; PG8_WAIT_L(0); PG8_MMA(0, 1, At, B1); PG8_BAR;
            PG8_LDA(At, 0, 1); PG8_STAGE(PG8_SA(0, 0), a2, voffA);
            PG8_BAR; PG8_WAIT_L(0); PG8_MMA(1, 0, At, B0); PG8_BAR; PG8_SCHED;
            PG8_STAGE(PG8_SB(0, 1), b2 + hstep, voffB);
            PG8_WAIT_V(6); PG8_BAR; PG8_MMA(1, 1, At, B1); PG8_BAR;
            PG8_LDB(B0, 1, 0); PG8_SCHED; PG8_LDA(At, 1, 0); PG8_STAGE(PG8_SA(0, 1), a2 + hstep, voffA);
            PG8_WAIT_L(8); PG8_BAR; PG8_WAIT_L(0); PG8_MMA(0, 0, At, B0); PG8_BAR; PG8_SCHED;
            PG8_LDB(B1, 1, 1); PG8_STAGE(PG8_SB(1, 0), b3, voffB);
            PG8_BAR; PG8_WAIT_L(0); PG8_MMA(0, 1, At, B1); PG8_BAR;
            PG8_LDA(At, 1, 1); PG8_STAGE(PG8_SA(1, 0), a3, voffA);
            PG8_BAR; PG8_WAIT_L(0); PG8_MMA(1, 0, At, B0); PG8_BAR; PG8_SCHED;
            PG8_STAGE(PG8_SB(1, 1), b3 + hstep, voffB);
            PG8_WAIT_V(6); PG8_BAR; PG8_MMA(1, 1, At, B1); PG8_BAR;
            }
        }
        if constexpr (ALIGN_EPI) { if (wr == 0) PG8_BAR; }
        if constexpr (!Epi::AFTER_DRAIN) { E(acc, cur, wr, wc, fr, fq); S.done(cur); }
        if (!has_next) break;
#pragma unroll
        for (int a = 0; a < 2; ++a)
#pragma unroll
            for (int b = 0; b < 2; ++b)
#pragma unroll
                for (int m = 0; m < 4; ++m)
#pragma unroll
                    for (int n = 0; n < 2; ++n) acc[a][b][m][n] = (f32x4){0.f, 0.f, 0.f, 0.f};
        cur = nxt; cA = nA; cB = nB; ++ui;
        if constexpr (ALIGN_EPI) { if (wr == 1) PG8_BAR; }
    }
    PG8_WAIT_V(0);
    if constexpr (!ALIGN_EPI) { if (wr == 0) PG8_BAR; }
    PG8_BAR;
    if constexpr (Epi::AFTER_DRAIN) { E.fused(acc, cur, wr, wc, fr, fq, lds, wid, lane); S.done(cur); }
#undef PG8_SA
#undef PG8_SB
#undef PG8_STAGE
#undef PG8_LDA
#undef PG8_LDB
#undef PG8_MMA
#undef PG8_WAIT_V
#undef PG8_WAIT_L
#undef PG8_BAR
#undef PG8_SCHED
}
}
namespace attn_body {
__device__ __forceinline__ unsigned f2bf_dev(float f){unsigned u=__builtin_bit_cast(unsigned,f);return (u+0x7fffu+((u>>16)&1u))>>16;}
using bf16=unsigned short;
using bf16x8=__attribute__((ext_vector_type(8)))short;
using s16x4=__attribute__((ext_vector_type(4)))short;
using f32x16=__attribute__((ext_vector_type(16)))float;
using u32x4=__attribute__((ext_vector_type(4)))unsigned;
constexpr int D=64;
constexpr int NW=8,QBLK=32,KVBLK=64;
__device__ __forceinline__ int crow(int r,int hi){return (r&3)+8*(r>>2)+4*hi;}
#define SBAR() __builtin_amdgcn_sched_barrier(0)
constexpr int NSLOT=3, SLOTB=8192;
constexpr int LDS_K=0, LDS_V=NSLOT*SLOTB, LDS_WS=2*NSLOT*SLOTB, LDS_OST=LDS_WS+NW*64*4, LDS_BYTES=LDS_OST+NW*4096;
constexpr float C2=0.125f*1.4426950408889634f;
__device__ __forceinline__ void glds16(const void*gsrc,unsigned lds_dst){unsigned keep;
  asm volatile("s_mov_b32 %0, m0\n\ts_mov_b32 m0, %2\n\ts_nop 0\n\tglobal_load_lds_dwordx4 %1, off\n\ts_mov_b32 m0, %0":"=&s"(keep):"v"(gsrc),"s"(lds_dst):"memory");}
__device__ __forceinline__ float max3f(float a,float b,float c){float r;asm("v_max3_f32 %0, %1, %2, %3":"=v"(r):"v"(a),"v"(b),"v"(c));return r;}
__device__ __forceinline__ float max2f(float a,float b){float r;asm("v_max_f32_e32 %0, %1, %2":"=v"(r):"v"(a),"v"(b));return r;}
__device__ __forceinline__ float fadd_s(float a,float b){float r;asm("v_add_f32_e32 %0, %1, %2":"=v"(r):"v"(a),"v"(b));return r;}
__device__ __forceinline__ float fsub_s(float a,float b){float r;asm("v_sub_f32_e32 %0, %1, %2":"=v"(r):"v"(a),"v"(b));return r;}
typedef float f32x2_t __attribute__((ext_vector_type(2))); typedef __bf16 bf16x2_t __attribute__((ext_vector_type(2)));
__device__ __forceinline__ unsigned cvtpk_s(float lo,float hi){f32x2_t v={lo,hi};bf16x2_t b=__builtin_convertvector(v,bf16x2_t);return __builtin_bit_cast(unsigned,b);}
#define WAIT_BAR(N) asm volatile("s_waitcnt vmcnt(" #N ") lgkmcnt(0)\n\ts_barrier":::"memory")

__device__ __forceinline__ void qkt(f32x16&p0,f32x16&p1,const char*Kslot,const bf16x8*qr,const f32x16&negm,int r32,int hi){
  const char*kb=Kslot+hi*1024+r32*16;
  #pragma unroll
  for(int d0=0;d0<4;++d0){
    const bf16x8 b0=*reinterpret_cast<const bf16x8*>(kb+d0*2048);
    const bf16x8 b1=*reinterpret_cast<const bf16x8*>(kb+d0*2048+512);
    if(d0==0){p0=__builtin_amdgcn_mfma_f32_32x32x16_bf16(b0,qr[0],negm,0,0,0);p1=__builtin_amdgcn_mfma_f32_32x32x16_bf16(b1,qr[0],negm,0,0,0);}
    else{p0=__builtin_amdgcn_mfma_f32_32x32x16_bf16(b0,qr[d0],p0,0,0,0);p1=__builtin_amdgcn_mfma_f32_32x32x16_bf16(b1,qr[d0],p1,0,0,0);}}
}
typedef __attribute__((address_space(3))) const char* lds_cptr;
typedef short v4i16_t __attribute__((ext_vector_type(4)));
__device__ __forceinline__ void kload8(bf16x8*kf,lds_cptr kp){
  kf[0]=*(const __attribute__((address_space(3))) bf16x8*)(kp);      kf[1]=*(const __attribute__((address_space(3))) bf16x8*)(kp+512);
  kf[2]=*(const __attribute__((address_space(3))) bf16x8*)(kp+2048); kf[3]=*(const __attribute__((address_space(3))) bf16x8*)(kp+2560);
  kf[4]=*(const __attribute__((address_space(3))) bf16x8*)(kp+4096); kf[5]=*(const __attribute__((address_space(3))) bf16x8*)(kp+4608);
  kf[6]=*(const __attribute__((address_space(3))) bf16x8*)(kp+6144); kf[7]=*(const __attribute__((address_space(3))) bf16x8*)(kp+6656);
}
__device__ __forceinline__ void kload2(bf16x8*kf,lds_cptr kp,int j){ kf[2*j]=*(const __attribute__((address_space(3))) bf16x8*)(kp+j*2048); kf[2*j+1]=*(const __attribute__((address_space(3))) bf16x8*)(kp+j*2048+512); }
__device__ __forceinline__ s16x4 vtr(lds_cptr p){ return __builtin_bit_cast(s16x4,__builtin_amdgcn_ds_read_tr16_b64_v4i16((__attribute__((address_space(3))) v4i16_t*)p)); }
__device__ __forceinline__ float rowmax(const f32x16&p0,const f32x16&p1){
  float a=max3f(p0[0],p0[1],p1[0]),b=max3f(p0[2],p0[3],p1[1]);a=max3f(a,p1[2],p1[3]);
  #pragma unroll
  for(int r=4;r<16;r+=4){a=max3f(a,p0[r],p0[r+1]);b=max3f(b,p0[r+2],p0[r+3]);a=max3f(a,p1[r],p1[r+1]);b=max3f(b,p1[r+2],p1[r+3]);}
  const float m=max2f(a,b);
  auto rr=__builtin_amdgcn_permlane32_swap(__float_as_uint(m),__float_as_uint(m),false,false);
  return max2f(__uint_as_float(rr[0]),__uint_as_float(rr[1]));
}
__device__ __forceinline__ void pv(f32x16*o,int vb,bf16x8 pa0,bf16x8 pa1,bf16x8 pa2,bf16x8 pa3){
  #pragma unroll
  for(int d0=0;d0<2;++d0){s16x4 lo[4],hi[4];
    #pragma unroll
    for(int ks=0;ks<4;++ks){
      asm volatile("ds_read_b64_tr_b16 %0,%1 offset:%c2":"=&v"(lo[ks]):"v"(vb),"i"(d0*4096+ks*1024):"memory");
      asm volatile("ds_read_b64_tr_b16 %0,%1 offset:%c2":"=&v"(hi[ks]):"v"(vb),"i"(d0*4096+ks*1024+512):"memory");}
    asm volatile("s_waitcnt lgkmcnt(0)":::"memory");SBAR();
    #define PK(k) (bf16x8){lo[k][0],lo[k][1],lo[k][2],lo[k][3],hi[k][0],hi[k][1],hi[k][2],hi[k][3]}
    o[d0]=__builtin_amdgcn_mfma_f32_32x32x16_bf16(pa0,PK(0),o[d0],0,0,0);
    o[d0]=__builtin_amdgcn_mfma_f32_32x32x16_bf16(pa1,PK(1),o[d0],0,0,0);
    o[d0]=__builtin_amdgcn_mfma_f32_32x32x16_bf16(pa2,PK(2),o[d0],0,0,0);
    o[d0]=__builtin_amdgcn_mfma_f32_32x32x16_bf16(pa3,PK(3),o[d0],0,0,0);
    #undef PK
  }
}

#ifndef ATTN_STORE16
#define ATTN_STORE16(p,v) (*(u32x4*)(p)=(v))
#endif
template<int THRL,int QP,int KP,int OP> __device__ __forceinline__ void attn_unit(const bf16*Qw,const bf16*__restrict__ Kh,const bf16*__restrict__ Vh,bf16*Ow,const int NT,char*shm,const int tid){
  const int lane=tid&63,r32=lane&31,hi=lane>>5; const int wid=__builtin_amdgcn_readfirstlane(tid>>6);
  const unsigned lds0=(unsigned)(uintptr_t)shm;
  float*wsf=(float*)(shm+LDS_WS)+wid*64;
  const bf16*ksrc=Kh+(long)lane*KP+wid*8;
  const bf16*vsrc=Vh+(long)(16*(wid&3)+(lane>>2))*KP+(wid>>2)*32+(lane&3)*8;
  const unsigned kdst=lds0+LDS_K+wid*1024, vdst=lds0+LDS_V+wid*1024;
  #define DMA_K(t,slot) glds16(ksrc+(long)(t)*KVBLK*KP,(unsigned)__builtin_amdgcn_readfirstlane(kdst+(slot)))
  #define DMA_V(t,slot) glds16(vsrc+(long)(t)*KVBLK*KP,(unsigned)__builtin_amdgcn_readfirstlane(vdst+(slot)))
  const int vb0=(int)(lds0+LDS_V)+((lane>>4)&1)*32+(lane&3)*8+(4*hi+((lane&15)>>2))*64;
  const char*Kbase=shm+LDS_K; bf16x8 kf[8];
  const lds_cptr shm3=(lds_cptr)shm; const lds_cptr kp0=shm3+LDS_K+hi*1024+r32*16; const lds_cptr vp0=shm3+LDS_V+((lane>>4)&1)*32+(lane&3)*8+(4*hi+((lane&15)>>2))*64;
  DMA_K(0,0);DMA_V(0,0);DMA_K(1,SLOTB);
  bf16x8 qr[4];
  #pragma unroll
  for(int d0=0;d0<4;++d0)qr[d0]=*reinterpret_cast<const bf16x8*>(&Qw[(long)r32*QP+d0*16+hi*8]);
  float mhat=0.f,l_reg=0.f;f32x16 o[2];o[0]=f32x16{};o[1]=f32x16{};f32x16 negm=f32x16{};asm volatile("":"+v"(negm));
  #define CMASK(P0,P1,t) do{}while(0)
  bool resc=false;
  #define START(P0,P1) do{ const float rm=rowmax(P0,P1); resc=false; \
    { const float dl=rm; mhat=fadd_s(mhat,dl); \
      _Pragma("unroll") for(int r=0;r<16;++r){P0[r]=fsub_s(P0[r],dl);P1[r]=fsub_s(P1[r],dl);} \
      _Pragma("unroll") for(int r=0;r<16;++r)negm[r]=-mhat; asm volatile("":"+v"(negm)); } \
    _Pragma("unroll") for(int r=0;r<16;++r)P0[r]=__builtin_amdgcn_exp2f(P0[r]); }while(0)
  #define RESC() do{ if(resc){ asm volatile("s_waitcnt lgkmcnt(0)":::"memory"); \
      _Pragma("unroll") for(int d_=0;d_<2;++d_) _Pragma("unroll") for(int r=0;r<16;++r)o[d_][r]*=wsf[crow(r,hi)]; } }while(0)
  f32x16 pA0,pA1,pB0,pB1;
  int sl_prev=0,sl_cur=0,sl_next=SLOTB;
  #define ROT() do{sl_prev=sl_cur;sl_cur=sl_next;sl_next=(sl_next==(NSLOT-1)*SLOTB)?0:sl_next+SLOTB;}while(0)
  DMA_K(2,2*SLOTB);
  WAIT_BAR(3);
  qkt(pA0,pA1,Kbase,qr,negm,r32,hi);asm volatile("s_nop 15\n\ts_nop 7":"+v"(pA0),"+v"(pA1));CMASK(pA0,pA1,0);
  START(pA0,pA1);
  _Pragma("unroll") for(int r=0;r<16;++r)pA1[r]=__builtin_amdgcn_exp2f(pA1[r]);
  WAIT_BAR(0);
  DMA_K(3,0);DMA_V(1,SLOTB);
  ROT();
  kload8(kf,kp0+sl_cur);
  WAIT_BAR(2);
  s16x4 vlo[8],vhi[8]; u32x4 pw0,pw1,pw2,pw3;
  #define PKW(P,B) cvtpk_s(P[B],P[B+1])
  #define PAF(k) __builtin_bit_cast(bf16x8,pw##k)
  #define VFR(i) (bf16x8){vlo[i][0],vlo[i][1],vlo[i][2],vlo[i][3],vhi[i][0],vhi[i][1],vhi[i][2],vhi[i][3]}
  #define PIN(x) asm volatile("":"+v"(x))
  #define MX3(a,b,c) __builtin_fmaxf(__builtin_fmaxf((a),(b)),(c))
  #define GAPA(MF,A0,A1,A2,A3,W0,W1,PW) do{ MF; sacc+=A0; sacc+=A1; sacc+=A2; sacc+=A3; PIN(sacc); W0; W1; PIN(PW); SBAR(); }while(0)
  #define EX(v) __builtin_amdgcn_exp2f(v)
  #define GAPB(MF,X,B) do{ MF; X[B]=EX(X[B]); X[B+1]=EX(X[B+1]); X[B+2]=EX(X[B+2]); X[B+3]=EX(X[B+3]); PIN(X); SBAR(); }while(0)
  #define VRD(i) do{ vlo[i]=vtr(vp_+(((i)>>2)*4096+((i)&3)*1024)); vhi[i]=vtr(vp_+(((i)>>2)*4096+((i)&3)*1024+512)); }while(0)
  #define KRD(G,j) do{ if(G){ kload2(kf,kp0+sl_next,j); SBAR(); } }while(0)
  #define STEP(C0,C1,P0,P1,t,GK,GV,GL) do{ SBAR(); \
    const lds_cptr vp_=vp0+sl_prev; \
    VRD(0); SBAR(); float sacc=(P0[0]+P0[1]); \
    GAPA(C0=__builtin_amdgcn_mfma_f32_32x32x16_bf16(kf[0],qr[0],negm,0,0,0), P0[2],P0[3],P0[4],P0[5],     pw0[0]=PKW(P0,0), pw0[1]=PKW(P0,2), pw0); \
    VRD(4); SBAR(); GAPA(C1=__builtin_amdgcn_mfma_f32_32x32x16_bf16(kf[1],qr[0],negm,0,0,0), P0[6],P0[7],P0[8],P0[9],     pw0[2]=PKW(P0,4), pw0[3]=PKW(P0,6), pw0); \
    VRD(1); SBAR(); GAPA(C0=__builtin_amdgcn_mfma_f32_32x32x16_bf16(kf[2],qr[1],C0,0,0,0),   P0[10],P0[11],P0[12],P0[13], pw1[0]=PKW(P0,8), pw1[1]=PKW(P0,10), pw1); \
    VRD(5); SBAR(); GAPA(C1=__builtin_amdgcn_mfma_f32_32x32x16_bf16(kf[3],qr[1],C1,0,0,0),   P0[14],P0[15],P1[0],P1[1],   pw1[2]=PKW(P0,12),pw1[3]=PKW(P0,14), pw1); \
    VRD(2); SBAR(); GAPA(C0=__builtin_amdgcn_mfma_f32_32x32x16_bf16(kf[4],qr[2],C0,0,0,0),   P1[2],P1[3],P1[4],P1[5],     pw2[0]=PKW(P1,0), pw2[1]=PKW(P1,2), pw2); \
    VRD(6); SBAR(); GAPA(C1=__builtin_amdgcn_mfma_f32_32x32x16_bf16(kf[5],qr[2],C1,0,0,0),   P1[6],P1[7],P1[8],P1[9],     pw2[2]=PKW(P1,4), pw2[3]=PKW(P1,6), pw2); \
    VRD(3); SBAR(); GAPA(C0=__builtin_amdgcn_mfma_f32_32x32x16_bf16(kf[6],qr[3],C0,0,0,0),   P1[10],P1[11],P1[12],P1[13], pw3[0]=PKW(P1,8), pw3[1]=PKW(P1,10), pw3); \
    VRD(7); SBAR(); GAPA(C1=__builtin_amdgcn_mfma_f32_32x32x16_bf16(kf[7],qr[3],C1,0,0,0),   P1[14],P1[15],0.f,0.f,       pw3[2]=PKW(P1,12),pw3[3]=PKW(P1,14), pw3); \
    l_reg+=sacc; \
    if(GK){DMA_K((t)+3,sl_cur);} if(GV){DMA_V((t)+1,sl_next);} \
    CMASK(C0,C1,t); \
    { float a=MX3(C0[0],C0[1],C1[0]),b=MX3(C0[2],C0[3],C1[1]); a=MX3(a,C1[2],C1[3]); \
      _Pragma("unroll") for(int r=4;r<16;r+=4){a=MX3(a,C0[r],C0[r+1]);b=MX3(b,C0[r+2],C0[r+3]);a=MX3(a,C1[r],C1[r+1]);b=MX3(b,C1[r+2],C1[r+3]);} \
      float rm=__builtin_fmaxf(a,b); { auto rr=__builtin_amdgcn_permlane32_swap(__float_as_uint(rm),__float_as_uint(rm),false,false); rm=__builtin_fmaxf(__uint_as_float(rr[0]),__uint_as_float(rr[1])); } \
      resc=false; \
      if(__builtin_expect(__any(rm>(float)THRL),0)){ const float dl=__builtin_fmaxf(rm,0.f); mhat+=dl; \
        _Pragma("unroll") for(int r=0;r<16;++r){C0[r]-=dl;C1[r]-=dl;} \
        _Pragma("unroll") for(int r=0;r<16;++r)negm[r]=-mhat; asm volatile("":"+v"(negm)); \
        const float f=__builtin_amdgcn_exp2f(-dl); l_reg*=f; if(hi==0)wsf[r32]=f; resc=true; } } \
    SBAR(); \
    GAPB(o[0]=__builtin_amdgcn_mfma_f32_32x32x16_bf16(PAF(0),VFR(0),o[0],0,0,0), C0,0); \
    GAPB(o[1]=__builtin_amdgcn_mfma_f32_32x32x16_bf16(PAF(0),VFR(4),o[1],0,0,0), C0,4); \
    KRD(GL,0); GAPB(o[0]=__builtin_amdgcn_mfma_f32_32x32x16_bf16(PAF(1),VFR(1),o[0],0,0,0), C0,8); \
    KRD(GL,1); GAPB(o[1]=__builtin_amdgcn_mfma_f32_32x32x16_bf16(PAF(1),VFR(5),o[1],0,0,0), C0,12); \
    KRD(GL,2); GAPB(o[0]=__builtin_amdgcn_mfma_f32_32x32x16_bf16(PAF(2),VFR(2),o[0],0,0,0), C1,0); \
    KRD(GL,3); GAPB(o[1]=__builtin_amdgcn_mfma_f32_32x32x16_bf16(PAF(2),VFR(6),o[1],0,0,0), C1,4); \
    GAPB(o[0]=__builtin_amdgcn_mfma_f32_32x32x16_bf16(PAF(3),VFR(3),o[0],0,0,0), C1,8); \
    GAPB(o[1]=__builtin_amdgcn_mfma_f32_32x32x16_bf16(PAF(3),VFR(7),o[1],0,0,0), C1,12); \
    }while(0)
  int t=1;
  #undef CMASK
  #define CMASK(P0,P1,t) do{}while(0)
  for(;t+5<NT;t+=2){
    STEP(pB0,pB1,pA0,pA1,t,true,true,true);     WAIT_BAR(2); RESC(); ROT();
    STEP(pA0,pA1,pB0,pB1,t+1,true,true,true);   WAIT_BAR(2); RESC(); ROT();
  }
  #undef CMASK
  #define CMASK(P0,P1,t) do{}while(0)
  #define ENDW(tt) do{ if((tt)+3<NT){WAIT_BAR(2);} else if((tt)+2<NT){WAIT_BAR(1);} else {WAIT_BAR(0);} }while(0)
  for(;t+1<NT;t+=2){
    STEP(pB0,pB1,pA0,pA1,t,(t+3<NT),(t+1<NT),(t+1<NT));       ENDW(t);   RESC(); ROT();
    STEP(pA0,pA1,pB0,pB1,t+1,(t+4<NT),(t+2<NT),(t+2<NT));     ENDW(t+1); RESC(); ROT();
  }
  STEP(pB0,pB1,pA0,pA1,NT-1,false,false,false); RESC();
  { float sacc=pB0[0]+pB0[1]; _Pragma("unroll") for(int r=2;r<16;++r)sacc+=pB0[r]; _Pragma("unroll") for(int r=0;r<16;++r)sacc+=pB1[r]; l_reg+=sacc;
    pw0=(u32x4){PKW(pB0,0),PKW(pB0,2),PKW(pB0,4),PKW(pB0,6)};pw1=(u32x4){PKW(pB0,8),PKW(pB0,10),PKW(pB0,12),PKW(pB0,14)};pw2=(u32x4){PKW(pB1,0),PKW(pB1,2),PKW(pB1,4),PKW(pB1,6)};pw3=(u32x4){PKW(pB1,8),PKW(pB1,10),PKW(pB1,12),PKW(pB1,14)};
    SBAR(); pv(o,vb0+sl_cur,PAF(0),PAF(1),PAF(2),PAF(3)); }
  #undef PKW
  #undef PAF
  #undef VFR
  #undef PIN
  #undef MX3
  #undef GAPA
  #undef GAPB
  #undef EX
  #undef VRD
  #undef KRD
  #undef STEP
  #undef ENDW
  {auto rr=__builtin_amdgcn_permlane32_swap(__float_as_uint(l_reg),__float_as_uint(l_reg),false,false);l_reg=__uint_as_float(rr[0])+__uint_as_float(rr[1]);}
  if(hi==0)wsf[32+r32]=l_reg;asm volatile("s_waitcnt lgkmcnt(0)":::"memory");
  float rli[16];
  #pragma unroll
  for(int r=0;r<16;++r)rli[r]=__builtin_amdgcn_rcpf(wsf[32+crow(r,hi)]);
  { bf16*stg=(bf16*)(shm+LDS_OST)+wid*2048;
    #pragma unroll
    for(int r=0;r<16;++r){const int orow=crow(r,hi);
      #pragma unroll
      for(int d0=0;d0<2;++d0)stg[orow*64+d0*32+r32]=(bf16)f2bf_dev(o[d0][r]*rli[r]);}
    asm volatile("s_waitcnt lgkmcnt(0)":::"memory");
    #pragma unroll
    for(int i=0;i<4;++i){const int row=i*8+(lane>>3),ch=lane&7; const u32x4 v=*(const u32x4*)(stg+row*64+ch*8); ATTN_STORE16(Ow+(long)row*OP+ch*8,v);} }
  asm volatile("s_waitcnt lgkmcnt(0)\n\ts_barrier":::"memory");
  #undef DMA_K
  #undef DMA_V
  #undef CMASK
  #undef START
  #undef RESC
  #undef ROT
}
constexpr int ATTN_LDS_BYTES=LDS_BYTES;
}

constexpr int SEQ = 16384, BATCH = 2, MTOK = BATCH * SEQ, DM = 1024, DEPTH = 4;
constexpr int NQH = 12, NKVH = 3, NMH = 4, NMEM = 256;
constexpr int QW = 768, KVW = 192, QMW = 256, INW = 1408, INWP = 1536, DFF = 2816, GUW = 5632;
constexpr float EPS = 1e-6f;
constexpr float QSCALE = 0.125f * 1.4426950408889634f;

typedef unsigned short bf16_t;
typedef short bf16x8 __attribute__((ext_vector_type(8)));
typedef float f32x4 __attribute__((ext_vector_type(4)));
typedef float f32x16 __attribute__((ext_vector_type(16)));
typedef unsigned u32x4 __attribute__((ext_vector_type(4)));
typedef unsigned u32x2 __attribute__((ext_vector_type(2)));
#define LAS __attribute__((address_space(3)))

constexpr size_t MiB = 1u << 20;
constexpr size_t WS_TAB = 0;
constexpr size_t WS_MEMN = 2 * MiB;
constexpr size_t WS_KVM = 3 * MiB;
constexpr size_t WS_LSE = 5 * MiB;
constexpr size_t WS_CTL = 7 * MiB, CTL_BYTES = 16384;
constexpr size_t WS_W = 8 * MiB;
constexpr size_t W_LAYER = 23 * MiB, WO_IN = 0, WO_O = 3 * MiB, WO_GU = 5 * MiB, WO_D = 16 * MiB;
constexpr size_t WS_WKV = WS_W + 4 * W_LAYER;
constexpr size_t WS_HB = 104 * MiB;
constexpr size_t WS_OB = 168 * MiB;
constexpr size_t WS_R1 = 232 * MiB;
constexpr size_t WS_Q = WS_R1, WS_K = WS_Q + 48 * MiB, WS_V = WS_K + 12 * MiB, WS_QM = WS_V + 12 * MiB, WS_CTX = WS_QM + 16 * MiB;
constexpr size_t WS_END = WS_R1 + 176 * MiB;

struct Params {
    const float* x; const float* mem; const float* mem_g; const float* w_in; const float* w_kv; const float* w_o;
    const float* g_mix_pre; const float* g_mix_post; const float* sink; const float* qk_g;
    const float* w_gu; const float* w_d; const float* g_ffn_pre; const float* g_ffn_post;
    float* out; unsigned char* ws;
    float invp[8]; float inva[16];
    int ph_lo, ph_hi;
};

__device__ __forceinline__ unsigned f2bf(float f) { unsigned u = __builtin_bit_cast(unsigned, f); return (u + 0x7fffu + ((u >> 16) & 1u)) >> 16; }
__device__ __forceinline__ unsigned pk2(float lo, float hi) { return pg8::cvt_pk_bf16(lo, hi); }
__device__ __forceinline__ float bflo(unsigned w) { return __builtin_bit_cast(float, w << 16); }
__device__ __forceinline__ float bfhi(unsigned w) { return __builtin_bit_cast(float, w & 0xffff0000u); }
__device__ __forceinline__ float wave_sum(float v) {
#pragma unroll
    for (int o = 1; o < 64; o <<= 1) v += __shfl_xor(v, o);
    return v;
}

struct EpiPlain {
    static constexpr bool PERM = true, AFTER_DRAIN = false;
    bf16_t* O; int ldc;
    __device__ __forceinline__ void operator()(const f32x4 (&acc)[2][2][4][2], const pg8::Unit& u, int wr, int wc, int fr, int fq) const {
        const int row0 = u.pm * 256 + wr * 64 + fr, col0 = u.pn * 256 + wc * 32 + 8 * fq;
#pragma unroll
        for (int ai = 0; ai < 2; ++ai)
#pragma unroll
            for (int m = 0; m < 4; ++m) { bf16_t* rowp = O + (size_t)(row0 + ai * 128 + m * 16) * ldc + col0;
#pragma unroll
                for (int bj = 0; bj < 2; ++bj) { const f32x4 v0 = acc[ai][bj][m][0], v1 = acc[ai][bj][m][1];
                    u32x4 w; w.x = pk2(v0[0], v0[1]); w.y = pk2(v0[2], v0[3]); w.z = pk2(v1[0], v1[1]); w.w = pk2(v1[2], v1[3]);
                    *(u32x4*)(rowp + bj * 128) = w; } }
    }
};
struct EpiSwiGLU {
    static constexpr bool PERM = true, AFTER_DRAIN = false;
    bf16_t* O; int ldc;
    __device__ __forceinline__ void operator()(const f32x4 (&acc)[2][2][4][2], const pg8::Unit& u, int wr, int wc, int fr, int fq) const {
        const int row0 = u.pm * 256 + wr * 64 + fr, col0 = u.pn * 128 + wc * 32 + 8 * fq;
#pragma unroll
        for (int ai = 0; ai < 2; ++ai)
#pragma unroll
            for (int m = 0; m < 4; ++m) { bf16_t* rowp = O + (size_t)(row0 + ai * 128 + m * 16) * ldc + col0;
                float r[8];
#pragma unroll
                for (int n = 0; n < 2; ++n)
#pragma unroll
                    for (int j = 0; j < 4; ++j) { const float g = acc[ai][0][m][n][j], up = acc[ai][1][m][n][j];
                        const float s = __builtin_amdgcn_rcpf(1.0f + __builtin_amdgcn_exp2f(-1.4426950408889634f * g));
                        r[n * 4 + j] = g * s * up; }
                u32x4 w; w.x = pk2(r[0], r[1]); w.y = pk2(r[2], r[3]); w.z = pk2(r[4], r[5]); w.w = pk2(r[6], r[7]);
                *(u32x4*)rowp = w; }
    }
};
struct EpiIn {
    static constexpr bool PERM = true, AFTER_DRAIN = false;
    bf16_t *Q, *K, *V, *QM; int kind;
    const float *cosp, *sinp, *cosa, *sina; const float* qkg;
    __device__ __forceinline__ void operator()(const f32x4 (&acc)[2][2][4][2], const pg8::Unit& u, int wr, int wc, int fr, int fq) const {
        const int vh = 4 * u.pn + wc; if (vh >= 22) return;
        const int row0 = u.pm * 256 + wr * 64 + fr;
        const bool isq = vh < 12, isk = vh >= 12 && vh < 15, isv = vh >= 15 && vh < 18;
        bf16_t* base; int ld;
        if (isq) { base = Q + vh * 64; ld = QW; } else if (isk) { base = K + (vh - 12) * 64; ld = KVW; } else if (isv) { base = V + (vh - 15) * 64; ld = KVW; } else { base = QM + (vh - 18) * 64; ld = QMW; }
        const float osc = (isq || (!isk && !isv)) ? QSCALE : 1.0f;
#pragma unroll
        for (int ai = 0; ai < 2; ++ai)
#pragma unroll
            for (int m = 0; m < 4; ++m) {
                const int row = row0 + ai * 128 + m * 16, t = row & (SEQ - 1);
                float v[2][8];
#pragma unroll
                for (int bj = 0; bj < 2; ++bj)
#pragma unroll
                    for (int n = 0; n < 2; ++n)
#pragma unroll
                        for (int j = 0; j < 4; ++j) v[bj][n * 4 + j] = acc[ai][bj][m][n][j];
                if (isq || isk) {
                    if (kind == 1) {
                        float ss = 0.f;
#pragma unroll
                        for (int bj = 0; bj < 2; ++bj)
#pragma unroll
                            for (int e = 0; e < 8; ++e) ss += v[bj][e] * v[bj][e];
                        ss += __shfl_xor(ss, 16); ss += __shfl_xor(ss, 32);
                        const float rs = 1.0f / sqrtf(ss * (1.0f / 64.0f) + EPS);
                        const float* gp = qkg + (isk ? 64 : 0) + 8 * fq;
#pragma unroll
                        for (int bj = 0; bj < 2; ++bj) { const f32x4 g0 = *(const f32x4*)(gp + 32 * bj), g1 = *(const f32x4*)(gp + 32 * bj + 4);
#pragma unroll
                            for (int e = 0; e < 4; ++e) { v[bj][e] *= rs * g0[e]; v[bj][4 + e] *= rs * g1[e]; } }
#pragma unroll
                        for (int bj = 0; bj < 2; ++bj) {
                            const int ti = (bj == 0 ? (t >> 6) : (t & 63)) * 16 + 8 * (fq & 1);
                            const f32x4 c0 = *(const f32x4*)(cosa + ti), c1 = *(const f32x4*)(cosa + ti + 4), s0 = *(const f32x4*)(sina + ti), s1 = *(const f32x4*)(sina + ti + 4);
#pragma unroll
                            for (int e = 0; e < 8; ++e) { const float pr = __shfl_xor(v[bj][e], 32); const float c = e < 4 ? c0[e & 3] : c1[e & 3], s = e < 4 ? s0[e & 3] : s1[e & 3];
                                v[bj][e] = v[bj][e] * c + (fq < 2 ? -pr : pr) * s; }
                        }
                    } else {
                        const f32x4 c0 = *(const f32x4*)(cosp + t * 8), c1 = *(const f32x4*)(cosp + t * 8 + 4), s0 = *(const f32x4*)(sinp + t * 8), s1 = *(const f32x4*)(sinp + t * 8 + 4);
#pragma unroll
                        for (int e = 0; e < 8; ++e) { const float pr = __shfl_xor(v[0][e], 16); const float c = e < 4 ? c0[e & 3] : c1[e & 3], s = e < 4 ? s0[e & 3] : s1[e & 3];
                            const float rv = v[0][e] * c + (fq == 0 ? -pr : pr) * s; v[0][e] = fq < 2 ? rv : v[0][e]; }
                    }
                }
                bf16_t* rowp = base + (size_t)row * ld + 8 * fq;
#pragma unroll
                for (int bj = 0; bj < 2; ++bj) { u32x4 w; w.x = pk2(v[bj][0] * osc, v[bj][1] * osc); w.y = pk2(v[bj][2] * osc, v[bj][3] * osc); w.z = pk2(v[bj][4] * osc, v[bj][5] * osc); w.w = pk2(v[bj][6] * osc, v[bj][7] * osc);
                    *(u32x4*)(rowp + 32 * bj) = w; }
            }
    }
};

__device__ __forceinline__ void transpose_item(const float* W, int K, int ldw, bf16_t* WT, int dst_row0, int src_col0, const float* gk, LAS float* scr, int kb, int lane) {
    const int k0 = 64 * kb;
#pragma unroll 8
    for (int i = 0; i < 32; ++i) { const int kk = 2 * i + (lane >> 5); float val = 0.f;
        if (src_col0 >= 0) { val = W[(size_t)(k0 + kk) * ldw + src_col0 + (lane & 31)]; if (gk) val *= gk[k0 + kk]; }
        scr[kk * 33 + (lane & 31)] = val; }
    asm volatile("s_waitcnt lgkmcnt(0)" ::: "memory");
    const int c = lane & 7;
#pragma unroll
    for (int j = 0; j < 4; ++j) { const int n = (lane >> 3) + 8 * j; const LAS float* s = scr + (8 * c) * 33 + n;
        u32x4 o; o.x = pk2(s[0 * 33], s[1 * 33]); o.y = pk2(s[2 * 33], s[3 * 33]); o.z = pk2(s[4 * 33], s[5 * 33]); o.w = pk2(s[6 * 33], s[7 * 33]);
        *(u32x4*)(WT + (size_t)(dst_row0 + n) * K + k0 + 8 * c) = o; }
    asm volatile("s_waitcnt lgkmcnt(0)" ::: "memory");
}
__device__ __forceinline__ void row_pass(const bf16_t* ob, const float* g, const float* xi, float* xo, bf16_t* hb, const float* g2, int lane) {
    f32x4 x[4];
#pragma unroll
    for (int j = 0; j < 4; ++j) x[j] = *(const f32x4*)(xi + 4 * lane + 256 * j);
    if (ob) {
        f32x4 o[4]; float ss = 0.f;
#pragma unroll
        for (int j = 0; j < 4; ++j) { const u32x2 w = *(const u32x2*)(ob + 4 * lane + 256 * j); o[j] = (f32x4){bflo(w.x), bfhi(w.x), bflo(w.y), bfhi(w.y)};
            ss += (o[j][0] * o[j][0] + o[j][1] * o[j][1]) + (o[j][2] * o[j][2] + o[j][3] * o[j][3]); }
        const float rs = 1.0f / sqrtf(wave_sum(ss) * (1.0f / DM) + EPS);
#pragma unroll
        for (int j = 0; j < 4; ++j) { const f32x4 gv = *(const f32x4*)(g + 4 * lane + 256 * j); x[j] = x[j] + o[j] * rs * gv; }
#pragma unroll
        for (int j = 0; j < 4; ++j) *(f32x4*)(xo + 4 * lane + 256 * j) = x[j];
    }
    if (hb) {
        float ss = 0.f;
#pragma unroll
        for (int j = 0; j < 4; ++j) ss += (x[j][0] * x[j][0] + x[j][1] * x[j][1]) + (x[j][2] * x[j][2] + x[j][3] * x[j][3]);
        const float rs = 1.0f / sqrtf(wave_sum(ss) * (1.0f / DM) + EPS);
#pragma unroll
        for (int j = 0; j < 4; ++j) { f32x4 y = x[j] * rs; if (g2) y = y * *(const f32x4*)(g2 + 4 * lane + 256 * j);
            u32x2 w; w.x = pk2(y[0], y[1]); w.y = pk2(y[2], y[3]); *(u32x2*)(hb + 4 * lane + 256 * j) = w; }
    }
}

constexpr int AT_PITCH = 72, AT_TILE_B = 64 * AT_PITCH * 2, AT_K = 0, AT_V = 2 * AT_TILE_B;
__device__ __forceinline__ int crow(int r, int hi) { return (r & 3) + 8 * (r >> 2) + 4 * hi; }
__device__ __forceinline__ void attn_unit(LAS unsigned char* lds, const bf16_t* Qp, int qpitch, long qrowbase, int qstride, int iq,
                                          const bf16_t* Kp, const bf16_t* Vp, int kpitch, long krowbase, int kstride,
                                          int t_lo, int t_hi, int R, int q0blk,
                                          bf16_t* Op, int opitch, float* lsep, float sink_l2, bool has_sink, const int tid) {
    const int lane = tid & 63, r32 = lane & 31, hi = lane >> 5, wid = __builtin_amdgcn_readfirstlane(tid >> 6);
    const long qrow = qrowbase + (long)iq * qstride;
    bf16x8 qr[4];
#pragma unroll
    for (int d0 = 0; d0 < 4; ++d0) qr[d0] = *(const bf16x8*)(Qp + qrow * qpitch + d0 * 16 + hi * 8);
    float mrun = -1e30f, lrun = 0.f; f32x16 o[2];
#pragma unroll
    for (int r = 0; r < 16; ++r) { o[0][r] = 0.f; o[1][r] = 0.f; }
    const int vpos = (lane & ~15) + 8 * ((lane >> 2) & 1) + (lane & 3) + 4 * ((lane >> 3) & 1);
    u32x4 kreg, vreg;
    { const long kr = krowbase + (long)(t_lo * 64 + lane) * kstride; kreg = *(const u32x4*)(Kp + kr * kpitch + wid * 8); vreg = *(const u32x4*)(Vp + kr * kpitch + wid * 8); }
    for (int t = t_lo; t < t_hi; ++t) {
        const int buf = (t - t_lo) & 1;
        LAS unsigned char* ks = lds + AT_K + buf * AT_TILE_B; LAS unsigned char* vt = lds + AT_V + buf * AT_TILE_B;
        *(LAS u32x4*)(ks + lane * (AT_PITCH * 2) + wid * 16) = kreg;
        { LAS bf16_t* vb = (LAS bf16_t*)vt + (wid * 8) * AT_PITCH + vpos;
          vb[0 * AT_PITCH] = (bf16_t)(vreg.x & 0xffff); vb[1 * AT_PITCH] = (bf16_t)(vreg.x >> 16); vb[2 * AT_PITCH] = (bf16_t)(vreg.y & 0xffff); vb[3 * AT_PITCH] = (bf16_t)(vreg.y >> 16);
          vb[4 * AT_PITCH] = (bf16_t)(vreg.z & 0xffff); vb[5 * AT_PITCH] = (bf16_t)(vreg.z >> 16); vb[6 * AT_PITCH] = (bf16_t)(vreg.w & 0xffff); vb[7 * AT_PITCH] = (bf16_t)(vreg.w >> 16); }
        __syncthreads();
        if (t + 1 < t_hi) { const long kr = krowbase + (long)((t + 1) * 64 + lane) * kstride; kreg = *(const u32x4*)(Kp + kr * kpitch + wid * 8); vreg = *(const u32x4*)(Vp + kr * kpitch + wid * 8); }
        f32x16 p0, p1;
#pragma unroll
        for (int r = 0; r < 16; ++r) { p0[r] = 0.f; p1[r] = 0.f; }
#pragma unroll
        for (int d0 = 0; d0 < 4; ++d0) {
            const bf16x8 b0 = *(const LAS bf16x8*)(ks + r32 * (AT_PITCH * 2) + d0 * 32 + hi * 16);
            const bf16x8 b1 = *(const LAS bf16x8*)(ks + (32 + r32) * (AT_PITCH * 2) + d0 * 32 + hi * 16);
            p0 = __builtin_amdgcn_mfma_f32_32x32x16_bf16(b0, qr[d0], p0, 0, 0, 0);
            p1 = __builtin_amdgcn_mfma_f32_32x32x16_bf16(b1, qr[d0], p1, 0, 0, 0);
        }
        { const int dmax1 = q0blk + 63 - 64 * t, dmax2 = 64 * t + 63 - q0blk;
          if (dmax1 > R || dmax2 > R) {
#pragma unroll
              for (int r = 0; r < 16; ++r) { const int kv = 64 * t + crow(r, hi); int d = kv - iq; d = d < 0 ? -d : d; if (d > R) p0[r] = -1e30f; int d2 = kv + 32 - iq; d2 = d2 < 0 ? -d2 : d2; if (d2 > R) p1[r] = -1e30f; }
          } }
        float mt = fmaxf(p0[0], p1[0]);
#pragma unroll
        for (int r = 1; r < 16; ++r) mt = fmaxf(mt, fmaxf(p0[r], p1[r]));
        mt = fmaxf(mt, __shfl_xor(mt, 32));
        const float mnew = fmaxf(mrun, mt), alpha = __builtin_amdgcn_exp2f(mrun - mnew); mrun = mnew;
        float sum = 0.f;
#pragma unroll
        for (int r = 0; r < 16; ++r) { p0[r] = __builtin_amdgcn_exp2f(p0[r] - mnew); p1[r] = __builtin_amdgcn_exp2f(p1[r] - mnew); sum += p0[r] + p1[r]; }
        lrun = lrun * alpha + sum;
#pragma unroll
        for (int r = 0; r < 16; ++r) { o[0][r] *= alpha; o[1][r] *= alpha; }
        u32x4 pw[4];
        pw[0] = (u32x4){pk2(p0[0], p0[1]), pk2(p0[2], p0[3]), pk2(p0[4], p0[5]), pk2(p0[6], p0[7])};
        pw[1] = (u32x4){pk2(p0[8], p0[9]), pk2(p0[10], p0[11]), pk2(p0[12], p0[13]), pk2(p0[14], p0[15])};
        pw[2] = (u32x4){pk2(p1[0], p1[1]), pk2(p1[2], p1[3]), pk2(p1[4], p1[5]), pk2(p1[6], p1[7])};
        pw[3] = (u32x4){pk2(p1[8], p1[9]), pk2(p1[10], p1[11]), pk2(p1[12], p1[13]), pk2(p1[14], p1[15])};
#pragma unroll
        for (int d0 = 0; d0 < 2; ++d0)
#pragma unroll
            for (int ksx = 0; ksx < 4; ++ksx) {
                const bf16x8 vf = *(const LAS bf16x8*)(vt + (32 * d0 + r32) * (AT_PITCH * 2) + ksx * 32 + hi * 16);
                o[d0] = __builtin_amdgcn_mfma_f32_32x32x16_bf16(vf, __builtin_bit_cast(bf16x8, pw[ksx]), o[d0], 0, 0, 0);
            }
    }
    lrun += __shfl_xor(lrun, 32);
    if (has_sink) lrun += __builtin_amdgcn_exp2f(sink_l2 - mrun);
    const float inv = 1.0f / lrun;
    bf16_t* orow = Op + qrow * opitch;
#pragma unroll
    for (int d0 = 0; d0 < 2; ++d0)
#pragma unroll
        for (int rq = 0; rq < 4; ++rq) { u32x2 w; w.x = pk2(o[d0][4 * rq] * inv, o[d0][4 * rq + 1] * inv); w.y = pk2(o[d0][4 * rq + 2] * inv, o[d0][4 * rq + 3] * inv);
            *(u32x2*)(orow + 32 * d0 + 8 * rq + 4 * hi) = w; }
    if (lsep && hi == 0) lsep[qrow * 12] = mrun + __builtin_log2f(lrun);
    __syncthreads();
}
#define XB_TMO      128
#define XB_XCNT(j)  (256  + 64 * (j))
#define XB_XSUB(j)  (1280 + 64 * (j))
#define XB_XGEN(j)  (2304 + 64 * (j))
#define XB_TOP      3328
#define XB_TOPGEN   3392
#define XCD_BAR_WORDS 3456
#define XB_SPIN_CAP (1u << 18)

__device__ __forceinline__ unsigned xb_ld(unsigned* p)              { return __hip_atomic_load(p, __ATOMIC_RELAXED, __HIP_MEMORY_SCOPE_AGENT); }
__device__ __forceinline__ unsigned xb_add(unsigned* p, unsigned v) { return __hip_atomic_fetch_add(p, v, __ATOMIC_RELAXED, __HIP_MEMORY_SCOPE_AGENT); }
__device__ __forceinline__ unsigned xb_xcc_id() { return (unsigned)__builtin_amdgcn_s_getreg((3 << 11) | 20) & 0xFu; }
#define XB_SPIN(cond, bar) do { unsigned _sp = 0; while (cond) { __builtin_amdgcn_s_sleep(1); \
    if ((++_sp & 255u) == 0u) { if (xb_ld(&(bar)[XB_TMO])) break; if (_sp > XB_SPIN_CAP) { atomicAdd(&(bar)[XB_TMO], 1u); break; } } } } while (0)

struct XcdBarrier {
    unsigned* bar; unsigned x;
    volatile LAS unsigned* st;
};

__device__ __forceinline__ XcdBarrier xcd_barrier_post(unsigned* bar, volatile LAS unsigned* st) {
    XcdBarrier b; b.bar = bar; b.x = xb_xcc_id(); b.st = st;
    if (threadIdx.x == 0) (void)xb_add(&bar[XB_XCNT(b.x)], 1u);
    return b;
}
__device__ __forceinline__ void xcd_barrier_complete(unsigned* bar, unsigned x, unsigned& nloc, unsigned& nx) {
    const unsigned G = gridDim.x * gridDim.y * gridDim.z;
    unsigned sum, cnt, mine, sp = 0u;
    for (;;) {
        sum = 0u; cnt = 0u; mine = 0u;
#pragma unroll
        for (unsigned j = 0; j < 16; ++j) { const unsigned c = xb_ld(&bar[XB_XCNT(j)]); sum += c; cnt += (c > 0u) ? 1u : 0u; mine = (j == x) ? c : mine; }
        if (sum == G) break;
        __builtin_amdgcn_s_sleep(1);
        if ((++sp & 255u) == 0u) { if (xb_ld(&bar[XB_TMO])) break; if (sp > XB_SPIN_CAP) { atomicAdd(&bar[XB_TMO], 1u); break; } }
    }
    nloc = mine > 0u ? mine : 1u; nx = cnt > 0u ? cnt : 1u;
}

__device__ __forceinline__ void xcd_barrier(const XcdBarrier& b) {
    asm volatile("s_waitcnt vmcnt(0)" ::: "memory");
    __syncthreads();
    if (threadIdx.x == 0) {
        unsigned* bar = b.bar;
        __builtin_amdgcn_s_waitcnt(0);
        unsigned nloc = b.st[0], nx = b.st[1];
        if (nloc == 0u) { xcd_barrier_complete(bar, b.x, nloc, nx); b.st[0] = nloc; b.st[1] = nx; }
        const unsigned old = xb_add(&bar[XB_XSUB(b.x)], 1u);
        const unsigned gen = old / nloc;
        if (old + 1u == (gen + 1u) * nloc) {
            __builtin_amdgcn_fence(__ATOMIC_RELEASE, "agent");
            asm volatile("s_waitcnt vmcnt(0)" ::: "memory");
            const unsigned og = xb_add(&bar[XB_TOP], 1u);
            const unsigned tg = og / nx;
            if (og + 1u == (tg + 1u) * nx) xb_add(&bar[XB_TOPGEN], 1u);
            else XB_SPIN(xb_ld(&bar[XB_TOPGEN]) == tg, bar);
            __builtin_amdgcn_fence(__ATOMIC_ACQUIRE, "agent");
            xb_add(&bar[XB_XGEN(b.x)], 1u);
            asm volatile("s_waitcnt vmcnt(0)" ::: "memory");
        } else {
            XB_SPIN(xb_ld(&bar[XB_XGEN(b.x)]) == gen, bar);
            __builtin_amdgcn_fence(__ATOMIC_ACQUIRE, "agent");
            asm volatile("s_waitcnt vmcnt(0)" ::: "memory");
        }
    }
    __syncthreads();
}

constexpr int LDS_BYTES = 131072 + 1024;
constexpr int NPHASES = 1 + 4 * 7 + 1;
#ifndef PROBE_ATT_L
#define PROBE_ATT_L -1
#endif

__device__ __forceinline__ float lse_weight(const float* L, int head) {
    const int j = head & 3; const float a = L[j], b = L[4 + j], c = L[8 + j], mine = L[head];
    const float m = fmaxf(a, fmaxf(b, c));
    const float s = __builtin_amdgcn_exp2f(a - m) + __builtin_amdgcn_exp2f(b - m) + __builtin_amdgcn_exp2f(c - m);
    return __builtin_amdgcn_exp2f(mine - m) / s;
}

__global__ void __launch_bounds__(512, 2) fwd_megakernel(Params p) {
    extern __shared__ __attribute__((aligned(16))) unsigned char lds_raw[];
    LAS unsigned char* lds = (LAS unsigned char*)lds_raw;
    cg::grid_group grid = cg::this_grid();
    const int tid = threadIdx.x, wid = __builtin_amdgcn_readfirstlane(tid >> 6);
    const int G = gridDim.x, gw = blockIdx.x * 8 + wid, NGW = G * 8;
    unsigned char* ws = p.ws;
    float* cosp = (float*)(ws + WS_TAB); float* sinp = cosp + SEQ * 8; float* cosa = sinp + SEQ * 8; float* sina = cosa + 256 * 16;
    bf16_t* MEMN = (bf16_t*)(ws + WS_MEMN); bf16_t* KVM = (bf16_t*)(ws + WS_KVM); float* LSE = (float*)(ws + WS_LSE);
    bf16_t* WKV = (bf16_t*)(ws + WS_WKV); bf16_t* HB = (bf16_t*)(ws + WS_HB); bf16_t* OB = (bf16_t*)(ws + WS_OB);
    bf16_t* Qb = (bf16_t*)(ws + WS_Q); bf16_t* Kb = (bf16_t*)(ws + WS_K); bf16_t* Vb = (bf16_t*)(ws + WS_V); bf16_t* QMb = (bf16_t*)(ws + WS_QM);
    bf16_t* CTX = (bf16_t*)(ws + WS_CTX); bf16_t* ACT = (bf16_t*)(ws + WS_R1);
    LAS unsigned* MISC = (LAS unsigned*)(lds + 131072);
    if (tid < 64) MISC[tid] = 0u;
    __syncthreads();
    const XcdBarrier bar = xcd_barrier_post((unsigned*)(ws + WS_CTL), (volatile LAS unsigned*)(MISC + 8));
    int ph = 0;
#define PH_ON (ph >= p.ph_lo && ph < p.ph_hi)
#define LAUNDER int tl_ = tid; asm volatile("" : "+v"(tl_)); const int lane = tl_ & 63; (void)lane
#define PH_END do { if (PH_ON && ph + 1 < p.ph_hi) { if (ph == 0) grid.sync(); else xcd_barrier(bar); } ++ph; } while (0)

    if (PH_ON) { LAUNDER;
        LAS float* scr = (LAS float*)(lds + wid * 16384);
        constexpr int I_IN = 16 * 48, I_O = 16 * 32, I_GU = 16 * 176, I_D = 44 * 32, I_KV = 16 * 16, I_L = I_IN + I_O + I_GU + I_D + I_KV;
        for (int it = gw; it < DEPTH * I_L; it += NGW) {
            const int l = it / I_L; int r = it % I_L;
            bf16_t* wl = (bf16_t*)(ws + WS_W + (size_t)l * W_LAYER);
            if (r < I_IN) { const int kb = r / 48, nb = r % 48, R0 = 32 * nb, tile = R0 >> 8, c = R0 & 255, vh = 4 * tile + ((c >> 5) & 3), src = vh < 22 ? 64 * vh + 32 * (c >> 7) : -1;
                transpose_item(p.w_in + (size_t)l * DM * INW, DM, INW, (bf16_t*)((unsigned char*)wl + WO_IN), R0, src, p.g_mix_pre + l * DM, scr, kb, lane); continue; }
            r -= I_IN;
            if (r < I_O) { const int kb = r / 32, nb = r % 32;
                transpose_item(p.w_o + (size_t)l * DM * DM, DM, DM, (bf16_t*)((unsigned char*)wl + WO_O), 32 * nb, 32 * nb, nullptr, scr, kb, lane); continue; }
            r -= I_O;
            if (r < I_GU) { const int kb = r / 176, nb = r % 176, R0 = 32 * nb, tile = R0 >> 8, c = R0 & 255, src = ((c >> 7) ? DFF : 0) + 128 * tile + (c & 127);
                transpose_item(p.w_gu + (size_t)l * DM * GUW, DM, GUW, (bf16_t*)((unsigned char*)wl + WO_GU), R0, src, p.g_ffn_pre + l * DM, scr, kb, lane); continue; }
            r -= I_GU;
            if (r < I_D) { const int kb = r / 32, nb = r % 32;
                transpose_item(p.w_d + (size_t)l * DFF * DM, DFF, DM, (bf16_t*)((unsigned char*)wl + WO_D), 32 * nb, 32 * nb, nullptr, scr, kb, lane); continue; }
            r -= I_D;
            { const int kb = r / 16, nb = r % 16;
                transpose_item(p.w_kv + (size_t)l * DM * 512, DM, 512, WKV + (size_t)l * 512 * DM, 32 * nb, 32 * nb, nullptr, scr, kb, lane); }
        }
        for (int e = blockIdx.x * 512 + tid; e < SEQ * 8; e += G * 512) {
            { const int t = e >> 3, i = e & 7; const float ang = (float)t * p.invp[i]; cosp[e] = cosf(ang); sinp[e] = sinf(ang); }
            if (e < 256 * 16) { const int t = e >> 4, i = e & 15; const float ang = (float)t * p.inva[i]; cosa[e] = cosf(ang); sina[e] = sinf(ang); }
        }
        for (int m = gw; m < BATCH * NMEM; m += NGW) row_pass(nullptr, nullptr, p.mem + (size_t)m * DM, nullptr, MEMN + (size_t)m * DM, p.mem_g, lane);
        for (int m = gw; m < MTOK; m += NGW) row_pass(nullptr, nullptr, p.x + (size_t)m * DM, nullptr, HB + (size_t)m * DM, nullptr, lane);
    }
    PH_END;

    for (int l = 0; l < DEPTH; ++l) {
        const int kind = l % 3;
        unsigned char* wl = ws + WS_W + (size_t)l * W_LAYER;
        if (PH_ON) { LAUNDER;
            if (l == 0) { pg8::Gemm g{MEMN, WKV, BATCH * NMEM, DEPTH * 512, DM}; pg8::StaticOrder S; S.init(BATCH * NMEM, DEPTH * 512, G, (int)blockIdx.x);
                EpiPlain E{KVM, DEPTH * 512}; pg8::gemm_phase<EpiPlain, pg8::StaticOrder, false, true>(lds, g, S, E, tl_); }
            pg8::Gemm g{HB, (const bf16_t*)(wl + WO_IN), MTOK, INWP, DM}; pg8::StaticOrder S; S.init(MTOK, INWP, G, (int)blockIdx.x);
            EpiIn E{Qb, Kb, Vb, QMb, kind, cosp, sinp, cosa, sina, p.qk_g + (l / 3) * 128};
            pg8::gemm_phase<EpiIn, pg8::StaticOrder, true, true>(lds, g, S, E, tl_);
        }
        PH_END;
        if (PH_ON) { LAUNDER;
            const int r32 = lane & 31;
            for (int rep = 0; rep < (l == PROBE_ATT_L ? 2 : 1); ++rep) {
            if (rep) xcd_barrier(bar);
            for (int u = blockIdx.x; u < 2048; u += G) {
                if (u < 1536 && kind == 1) {
                    const int b = u / 768, rem = u % 768, kvh = rem >> 8, qb = rem & 255, head = 4 * kvh + (wid & 3); const long row = (long)b * SEQ + 64 * qb + 32 * (wid >> 2);
                    attn_body::attn_unit<8, QW, KVW, DM>(Qb + row * QW + head * 64, Kb + (long)b * SEQ * KVW + kvh * 64, Vb + (long)b * SEQ * KVW + kvh * 64, CTX + row * DM + head * 64, 256, (char*)lds_raw, tl_);
                    continue;
                }
                if (false) {
                    const int v = u - 1536, b = v >> 8, h = (v >> 6) & 3, qb = v & 63; const long row = (long)b * SEQ + 256 * qb + 32 * wid;
                    const bf16_t* kp = KVM + (long)b * NMEM * (DEPTH * 512) + l * 512 + h * 64;
                    attn_body::attn_unit<8, QMW, DEPTH * 512, DM>(QMb + row * QMW + h * 64, kp, kp + 256, CTX + row * DM + QW + h * 64, 4, (char*)lds_raw, tl_);
                    continue;
                }
                const bf16_t *Qp, *Kp, *Vp; bf16_t* Op; float* lsep = nullptr; int qpitch, kpitch, stride = 1, iq, tl, th, R = 1 << 30, q0 = 0; long qrb, krb; float sk = 0.f; bool hs = false;
                if (u < 1536) {
                    const int b = u / 768, rem = u % 768, kvh = rem >> 8, w = rem & 255, j = wid & 3, half = wid >> 2, head = 4 * kvh + j;
                    Qp = Qb + head * 64; qpitch = QW; Kp = Kb + kvh * 64; Vp = Vb + kvh * 64; kpitch = KVW; Op = CTX + head * 64;
                    int qb = w; qrb = (long)b * SEQ; tl = 0; th = 256;
                    if (kind == 2) { const int dil = 1 << (2 * kvh), nblk = 256 / dil, res = w / nblk; qb = w % nblk; stride = dil; qrb += res;
                        tl = qb - 1 < 0 ? 0 : qb - 1; th = qb + 2 > nblk ? nblk : qb + 2; R = 64; lsep = LSE + head; }
                    else if (kind == 0) { tl = qb - 2 < 0 ? 0 : qb - 2; th = qb + 3 > 256 ? 256 : qb + 3; R = 128; sk = p.sink[(l / 3) * NQH + head] * 1.4426950408889634f; hs = true; }
                    krb = qrb; q0 = 64 * qb; iq = q0 + 32 * half + r32;
                } else {
                    const int v = u - 1536, b = v >> 8, h = (v >> 6) & 3, qb = v & 63;
                    Qp = QMb + h * 64; qpitch = QMW; Kp = KVM + l * 512 + h * 64; Vp = Kp + 256; kpitch = DEPTH * 512; Op = CTX + QW + h * 64;
                    qrb = (long)b * SEQ; krb = (long)b * NMEM; tl = 0; th = 4; iq = 256 * qb + 32 * wid + r32;
                }
                attn_unit(lds, Qp, qpitch, qrb, stride, iq, Kp, Vp, kpitch, krb, stride, tl, th, R, q0, Op, DM, lsep, sk, hs, tl_);
            }
            }
        }
        PH_END;
        if (kind == 2) {
            if (PH_ON) { LAUNDER;
                for (int m = gw; m < MTOK; m += NGW) { const float* L = LSE + (size_t)m * 12; bf16_t* rowp = CTX + (size_t)m * DM;
#pragma unroll
                    for (int cc = 0; cc < 2; ++cc) { const int c = lane + 64 * cc; if (c < 96) { const float wgt = lse_weight(L, c >> 3);
                        u32x4 v = *(u32x4*)(rowp + c * 8);
                        v.x = pk2(bflo(v.x) * wgt, bfhi(v.x) * wgt); v.y = pk2(bflo(v.y) * wgt, bfhi(v.y) * wgt); v.z = pk2(bflo(v.z) * wgt, bfhi(v.z) * wgt); v.w = pk2(bflo(v.w) * wgt, bfhi(v.w) * wgt);
                        *(u32x4*)(rowp + c * 8) = v; } } }
            }
            PH_END;
        }
        if (PH_ON) { LAUNDER; pg8::Gemm g{CTX, (const bf16_t*)(wl + WO_O), MTOK, DM, DM}; pg8::StaticOrder S; S.init(MTOK, DM, G, (int)blockIdx.x);
            EpiPlain E{OB, DM}; pg8::gemm_phase<EpiPlain, pg8::StaticOrder, true, true>(lds, g, S, E, tl_); }
        PH_END;
        if (PH_ON) { LAUNDER; const float* xi = l == 0 ? p.x : p.out;
            for (int m = gw; m < MTOK; m += NGW) row_pass(OB + (size_t)m * DM, p.g_mix_post + l * DM, xi + (size_t)m * DM, p.out + (size_t)m * DM, HB + (size_t)m * DM, nullptr, lane); }
        PH_END;
        if (PH_ON) { LAUNDER; pg8::Gemm g{HB, (const bf16_t*)(wl + WO_GU), MTOK, GUW, DM}; pg8::StaticOrder S; S.init(MTOK, GUW, G, (int)blockIdx.x);
            EpiSwiGLU E{ACT, DFF}; pg8::gemm_phase<EpiSwiGLU, pg8::StaticOrder, true, true>(lds, g, S, E, tl_); }
        PH_END;
        if (PH_ON) { LAUNDER; pg8::Gemm g{ACT, (const bf16_t*)(wl + WO_D), MTOK, DM, DFF}; pg8::StaticOrder S; S.init(MTOK, DM, G, (int)blockIdx.x);
            EpiPlain E{OB, DM}; pg8::gemm_phase<EpiPlain, pg8::StaticOrder, true, true>(lds, g, S, E, tl_); }
        PH_END;
        if (PH_ON) { LAUNDER; for (int m = gw; m < MTOK; m += NGW) row_pass(OB + (size_t)m * DM, p.g_ffn_post + l * DM, p.out + (size_t)m * DM, p.out + (size_t)m * DM, l + 1 < DEPTH ? HB + (size_t)m * DM : nullptr, nullptr, lane); }
        PH_END;
    }
#undef PH_ON
#undef PH_END
}

extern "C" void kernel_launch(void* const* d_in, const int* in_sizes, int n_in, void* d_out, int out_size, void* d_ws, size_t ws_size, hipStream_t stream) {
    static int grid = 0;
    if (grid == 0) {
        if (n_in != 14 || in_sizes[0] != MTOK * DM || out_size != MTOK * DM || ws_size < WS_END) { fprintf(stderr, "kernel_launch: unexpected shapes (n_in %d, in0 %d, out %d, ws %zu)\n", n_in, n_in > 0 ? in_sizes[0] : -1, out_size, ws_size); grid = -1; return; }
        int dev = 0, cus = 0, per_cu = 0;
        hipGetDevice(&dev); hipDeviceGetAttribute(&cus, hipDeviceAttributeMultiprocessorCount, dev);
        if (hipFuncSetAttribute((const void*)fwd_megakernel, hipFuncAttributeMaxDynamicSharedMemorySize, LDS_BYTES) != hipSuccess) { fprintf(stderr, "kernel_launch: hipFuncSetAttribute failed\n"); grid = -1; return; }
        hipOccupancyMaxActiveBlocksPerMultiprocessor(&per_cu, (const void*)fwd_megakernel, 512, LDS_BYTES);
        (void)hipGetLastError();
        if (per_cu < 1) fprintf(stderr, "kernel_launch: occupancy query says %d blocks/CU\n", per_cu);
        grid = cus;
    }
    if (grid < 0) return;
    if (hipMemsetAsync((char*)d_ws + WS_CTL, 0, CTL_BYTES, stream) != hipSuccess) { fprintf(stderr, "kernel_launch: memset failed\n"); return; }
    Params p{};
    p.x = (const float*)d_in[0]; p.mem = (const float*)d_in[1]; p.mem_g = (const float*)d_in[2]; p.w_in = (const float*)d_in[3]; p.w_kv = (const float*)d_in[4]; p.w_o = (const float*)d_in[5];
    p.g_mix_pre = (const float*)d_in[6]; p.g_mix_post = (const float*)d_in[7]; p.sink = (const float*)d_in[8]; p.qk_g = (const float*)d_in[9];
    p.w_gu = (const float*)d_in[10]; p.w_d = (const float*)d_in[11]; p.g_ffn_pre = (const float*)d_in[12]; p.g_ffn_post = (const float*)d_in[13];
    p.out = (float*)d_out; p.ws = (unsigned char*)d_ws;
    for (int i = 0; i < 8; ++i) p.invp[i] = powf(500000.0f, -((float)(2 * i) / 16.0f));
    for (int i = 0; i < 16; ++i) p.inva[i] = powf(10000.0f, -((float)(2 * i) / 32.0f));
    p.ph_lo = 0; p.ph_hi = NPHASES;
    void* args[] = {&p};
    hipError_t e = hipLaunchCooperativeKernel((const void*)fwd_megakernel, dim3(grid), dim3(512), args, LDS_BYTES, stream);
    if (e != hipSuccess) fprintf(stderr, "cooperative launch failed: %s (grid %d)\n", hipGetErrorString(e), grid);
}
```

```cpp
#include <hip/hip_runtime.h>
#include <hip/hip_cooperative_groups.h>
#include <cstdio>
#include <cstdint>
#include <cmath>
namespace cg = cooperative_groups;
namespace pg8 {
#define PG8_LAS __attribute__((address_space(3)))
typedef unsigned short bf16_t;
typedef short bf16x8 __attribute__((ext_vector_type(8)));
typedef float f32x4 __attribute__((ext_vector_type(4)));
typedef unsigned u32x4 __attribute__((ext_vector_type(4)));
constexpr int BM = 256, BK = 64, HALF = 128, HTB = HALF * BK * 2  , STAGE_BYTES = 8 * HTB, NXCD = 8, WGM = 8;

__host__ __device__ __forceinline__ int lds_byte(int r, int c) { const int st = (r >> 4) * 2 + (c >> 5), rr = r & 15, cc = c & 31, ob = rr * 64 + cc * 2; return st * 1024 + (ob ^ (((ob >> 9) & 1) << 5)); }
__host__ __device__ __forceinline__ void stage_rc(int b, int& R, int& C) { const int st = b / 1024, sb = b % 1024, swz = sb ^ (((sb >> 9) & 1) << 5); R = (st >> 1) * 16 + swz / 64; C = (st & 1) * 32 + (swz % 64) / 2; }
__host__ __device__ __forceinline__ int perm32(int rho) { const int n = rho >> 4, i = rho & 15; return 8 * (i >> 2) + 4 * n + (i & 3); }

struct Unit { int pm, pn; };
struct Gemm { const bf16_t* A; const bf16_t* Bt; int M, N, K; };

struct StaticOrder {
    int nM, nN, nwg, G, c;
    __host__ __device__ void init(int M, int N, int G_, int c_) { nM = M / BM; nN = N / BM; nwg = nM * nN; G = G_; c = c_; }
    __host__ __device__ bool next(int i, Unit& u) const {
        const long L = (long)i * G + c; if (L >= nwg) return false;
        int wgid = (int)L; { const int q = nwg / NXCD, r = nwg % NXCD, xcd = wgid % NXCD, off = wgid / NXCD; wgid = (xcd < r ? xcd * (q + 1) : r * (q + 1) + (xcd - r) * q) + off; }
        const int nig = WGM * nN, gid = wgid / nig, fm = gid * WGM, gsz = (nM - fm) < WGM ? (nM - fm) : WGM;
        u.pm = fm + ((wgid % nig) % gsz); u.pn = (wgid % nig) / gsz; return true;
    }
    __device__ __forceinline__ void a_ready(const Unit&) const {}
    __device__ __forceinline__ void done(const Unit&) const {}
};

__device__ __forceinline__ unsigned cvt_pk_bf16(float lo, float hi) { unsigned r; asm volatile("v_cvt_pk_bf16_f32 %0, %1, %2" : "=v"(r) : "v"(lo), "v"(hi)); return r; }
template <class Epi, class Sched, bool ALIGN_EPI = false, bool SP2 = false>
__device__ __forceinline__ void gemm_phase(PG8_LAS unsigned char* lds, const Gemm g, const Sched& S, const Epi& E, const int tid) {
    const int wid = __builtin_amdgcn_readfirstlane(tid >> 6), lane = tid & 63, wr = wid >> 2, wc = wid & 3, fr = lane & 15, fq = lane >> 4;
    const int K = g.K, nt = K / BK;
    unsigned voffA[2], voffB[2];
#pragma unroll
    for (int i = 0; i < 2; ++i) { int R, C; stage_rc(tid * 16 + i * 8192, R, C); const int Rb = Epi::PERM ? ((R & ~31) + perm32(R & 31)) : R;
        voffA[i] = (unsigned)(R * K + C) * 2u; voffB[i] = (unsigned)(Rb * K + C) * 2u; }
    const size_t kstep = (size_t)(BK * 2);
    const size_t hstep = (size_t)HALF * K * 2;
    const size_t tstep = 2 * hstep;
    const unsigned ldsw = (unsigned)wid * 1024u;
    const int aoff = lds_byte(wr * 64 + fr, fq * 8), boff = lds_byte(wc * 32 + fr, fq * 8);
#define PG8_SA(b, h) (((b) * 2 + (h)) * HTB)
#define PG8_SB(b, h) ((4 + (b) * 2 + (h)) * HTB)
#define PG8_STAGE(bufoff, gbase, voff) do { _Pragma("unroll") for (int _i = 0; _i < 2; ++_i) \
        __builtin_amdgcn_global_load_lds((const unsigned*)((const char*)(gbase) + (voff)[_i]), (PG8_LAS unsigned*)(lds + (bufoff) + ldsw + _i * 8192), 16, 0, 0); } while (0)
#define PG8_LDA(dst, b, h) do { _Pragma("unroll") for (int m = 0; m < 4; ++m) _Pragma("unroll") for (int k = 0; k < 2; ++k) dst[m][k] = *(const PG8_LAS bf16x8*)(lds + PG8_SA(b, h) + aoff + m * 2048 + k * 1024); } while (0)
#define PG8_LDB(dst, b, h) do { _Pragma("unroll") for (int n = 0; n < 2; ++n) _Pragma("unroll") for (int k = 0; k < 2; ++k) dst[n][k] = *(const PG8_LAS bf16x8*)(lds + PG8_SB(b, h) + boff + n * 2048 + k * 1024); } while (0)
#define PG8_MMA(ai, bj, At, Bt) do { __builtin_amdgcn_s_setprio(1); _Pragma("unroll") for (int m = 0; m < 4; ++m) _Pragma("unroll") for (int n = 0; n < 2; ++n) _Pragma("unroll") for (int k = 0; k < 2; ++k) \
        acc[ai][bj][m][n] = __builtin_amdgcn_mfma_f32_16x16x32_bf16(Bt[n][k], At[m][k], acc[ai][bj][m][n], 0, 0, 0); __builtin_amdgcn_s_setprio(0); } while (0)
#define PG8_WAIT_V(n) asm volatile("s_waitcnt vmcnt(" #n ")" ::: "memory")
#define PG8_WAIT_L(n) asm volatile("s_waitcnt lgkmcnt(" #n ")" ::: "memory")
#define PG8_BAR __builtin_amdgcn_s_barrier()
#define PG8_SCHED __builtin_amdgcn_sched_barrier(0)
    Unit cur, nxt; int ui = 0;
    if (!S.next(0, cur)) return;
    f32x4 acc[2][2][4][2];
#pragma unroll
    for (int a = 0; a < 2; ++a)
#pragma unroll
        for (int b = 0; b < 2; ++b)
#pragma unroll
            for (int m = 0; m < 4; ++m)
#pragma unroll
                for (int n = 0; n < 2; ++n) acc[a][b][m][n] = (f32x4){0.f, 0.f, 0.f, 0.f};
    bf16x8 At[4][2], B0[2][2], B1[2][2];
    const char* cA = (const char*)g.A + (size_t)cur.pm * tstep; const char* cB = (const char*)g.Bt + (size_t)cur.pn * tstep;
    S.a_ready(cur);
    if constexpr (SP2) {
        PG8_STAGE(PG8_SB(0, 0), cB, voffB); PG8_STAGE(PG8_SB(0, 1), cB + hstep, voffB); PG8_STAGE(PG8_SA(0, 0), cA, voffA); PG8_STAGE(PG8_SA(0, 1), cA + hstep, voffA);
        if (wr == 1) PG8_BAR;
        PG8_WAIT_V(2); PG8_BAR;
        PG8_STAGE(PG8_SB(1, 0), cB + kstep, voffB); PG8_STAGE(PG8_SA(1, 0), cA + kstep, voffA); PG8_STAGE(PG8_SB(1, 1), cB + hstep + kstep, voffB);
        PG8_WAIT_V(6); PG8_BAR;
    } else {
        PG8_STAGE(PG8_SB(0, 0), cB, voffB); PG8_STAGE(PG8_SA(0, 0), cA, voffA); PG8_STAGE(PG8_SB(0, 1), cB + hstep, voffB); PG8_STAGE(PG8_SA(0, 1), cA + hstep, voffA);
        if (wr == 1) PG8_BAR;
        PG8_WAIT_V(4); PG8_BAR;
        PG8_STAGE(PG8_SB(1, 0), cB + kstep, voffB); PG8_STAGE(PG8_SA(1, 0), cA + kstep, voffA); PG8_STAGE(PG8_SB(1, 1), cB + hstep + kstep, voffB);
        PG8_WAIT_V(6); PG8_BAR;
    }
    for (;;) {
        const bool has_next = S.next(ui + 1, nxt);
        const char* nA = has_next ? (const char*)g.A + (size_t)nxt.pm * tstep : cA; const char* nB = has_next ? (const char*)g.Bt + (size_t)nxt.pn * tstep : cB;
        for (int t = 0; t < nt; t += 2) {
            const bool last = (t == nt - 2);
            const char* a1 = cA + (size_t)(t + 1) * kstep;
            const char* a2 = last ? nA : cA + (size_t)(t + 2) * kstep; const char* b2 = last ? nB : cB + (size_t)(t + 2) * kstep;
            const char* a3 = a2 + kstep; const char* b3 = b2 + kstep;
            if (last && has_next) S.a_ready(nxt);
            if constexpr (SP2) {
            PG8_LDB(B0, 0, 0); PG8_LDB(B1, 0, 1); PG8_SCHED; PG8_LDA(At, 0, 0); PG8_STAGE(PG8_SA(1, 1), a1 + hstep, voffA);
            PG8_WAIT_V(8); PG8_WAIT_L(0); PG8_BAR; PG8_MMA(0, 0, At, B0); PG8_MMA(0, 1, At, B1); PG8_BAR; PG8_SCHED;
            PG8_LDA(At, 0, 1); PG8_STAGE(PG8_SB(0, 0), b2, voffB); PG8_STAGE(PG8_SB(0, 1), b2 + hstep, voffB); PG8_STAGE(PG8_SA(0, 0), a2, voffA);
            PG8_WAIT_V(8); PG8_WAIT_L(0); PG8_BAR; PG8_MMA(1, 0, At, B0); PG8_MMA(1, 1, At, B1); PG8_BAR; PG8_SCHED;
            PG8_LDB(B0, 1, 0); PG8_LDB(B1, 1, 1); PG8_SCHED; PG8_LDA(At, 1, 0); PG8_STAGE(PG8_SA(0, 1), a2 + hstep, voffA);
            PG8_WAIT_V(8); PG8_WAIT_L(0); PG8_BAR; PG8_MMA(0, 0, At, B0); PG8_MMA(0, 1, At, B1); PG8_BAR; PG8_SCHED;
            PG8_LDA(At, 1, 1); PG8_STAGE(PG8_SB(1, 0), b3, voffB); PG8_STAGE(PG8_SB(1, 1), b3 + hstep, voffB); PG8_STAGE(PG8_SA(1, 0), a3, voffA);
            PG8_WAIT_V(8); PG8_WAIT_L(0); PG8_BAR; PG8_MMA(1, 0, At, B0); PG8_MMA(1, 1, At, B1); PG8_BAR; PG8_SCHED;
            } else {
            PG8_LDB(B0, 0, 0); PG8_SCHED; PG8_LDA(At, 0, 0); PG8_STAGE(PG8_SA(1, 1), a1 + hstep, voffA);
            PG8_WAIT_L(8); PG8_BAR; PG8_WAIT_L(0); PG8_MMA(0, 0, At, B0); PG8_BAR; PG8_SCHED;
            PG8_LDB(B1, 0, 1); PG8_STAGE(PG8_SB(0, 0), b2, voffB);
            PG8_BAR; PG8_WAIT_L(0); PG8_MMA(0, 1, At, B1); PG8_BAR;
            PG8_LDA(At, 0, 1); PG8_STAGE(PG8_SA(0, 0), a2, voffA);
            PG8_BAR; PG8_WAIT_L(0); PG8_MMA(1, 0, At, B0); PG8_BAR; PG8_SCHED;
            PG8_STAGE(PG8_SB(0, 1), b2 + hstep, voffB);
            PG8_WAIT_V(6); PG8_BAR; PG8_MMA(1, 1, At, B1); PG8_BAR;
            PG8_LDB(B0, 1, 0); PG8_SCHED; PG8_LDA(At, 1, 0); PG8_STAGE(PG8_SA(0, 1), a2 + hstep, voffA);
            PG8_WAIT_L(8); PG8_BAR; PG8_WAIT_L(0); PG8_MMA(0, 0, At, B0); PG8_BAR; PG8_SCHED;
            PG8_LDB(B1, 1, 1); PG8_STAGE(PG8_SB(1, 0), b3, voffB);
            PG8_BAR; PG8_WAIT_L(0); PG8_MMA(0, 1, At, B1); PG8_BAR;
            PG8_LDA(At, 1, 1); PG8_STAGE(PG8_SA(1, 0), a3, voffA);
            PG8_BAR; PG8_WAIT_L(0); PG8_MMA(1, 0, At, B0); PG8_BAR; PG8_SCHED;
            PG8_STAGE(PG8_SB(1, 1), b3 + hstep, voffB);
            PG8_WAIT_V(6); PG8_BAR; PG8_MMA(1, 1, At, B1); PG8_BAR;
            }
        }
        if constexpr (ALIGN_EPI) { if (wr == 0) PG8_BAR; }
        if constexpr (!Epi::AFTER_DRAIN) { E(acc, cur, wr, wc, fr, fq); S.done(cur); }
        if (!has_next) break;
#pragma unroll
        for (int a = 0; a < 2; ++a)
#pragma unroll
            for (int b = 0; b < 2; ++b)
#pragma unroll
                for (int m = 0; m < 4; ++m)
#pragma unroll
                    for (int n = 0; n < 2; ++n) acc[a][b][m][n] = (f32x4){0.f, 0.f, 0.f, 0.f};
        cur = nxt; cA = nA; cB = nB; ++ui;
        if constexpr (ALIGN_EPI) { if (wr == 1) PG8_BAR; }
    }
    PG8_WAIT_V(0);
    if constexpr (!ALIGN_EPI) { if (wr == 0) PG8_BAR; }
    PG8_BAR;
    if constexpr (Epi::AFTER_DRAIN) { E.fused(acc, cur, wr, wc, fr, fq, lds, wid, lane); S.done(cur); }
#undef PG8_SA
#undef PG8_SB
#undef PG8_STAGE
#undef PG8_LDA
#undef PG8_LDB
#undef PG8_MMA
#undef PG8_WAIT_V
#undef PG8_WAIT_L
#undef PG8_BAR
#undef PG8_SCHED
}
}
namespace attn_body {
__device__ __forceinline__ unsigned f2bf_dev(float f){unsigned u=__builtin_bit_cast(unsigned,f);return (u+0x7fffu+((u>>16)&1u))>>16;}
using bf16=unsigned short;
using bf16x8=__attribute__((ext_vector_type(8)))short;
using s16x4=__attribute__((ext_vector_type(4)))short;
using f32x16=__attribute__((ext_vector_type(16)))float;
using u32x4=__attribute__((ext_vector_type(4)))unsigned;
constexpr int D=64;
constexpr int NW=8,QBLK=32,KVBLK=64;
__device__ __forceinline__ int crow(int r,int hi){return (r&3)+8*(r>>2)+4*hi;}
#define SBAR() __builtin_amdgcn_sched_barrier(0)
constexpr int NSLOT=3, SLOTB=8192;
constexpr int LDS_K=0, LDS_V=NSLOT*SLOTB, LDS_WS=2*NSLOT*SLOTB, LDS_OST=LDS_WS+NW*64*4, LDS_BYTES=LDS_OST+NW*4096;
constexpr float C2=0.125f*1.4426950408889634f;
__device__ __forceinline__ void glds16(const void*gsrc,unsigned lds_dst){unsigned keep;
  asm volatile("s_mov_b32 %0, m0\n\ts_mov_b32 m0, %2\n\ts_nop 0\n\tglobal_load_lds_dwordx4 %1, off\n\ts_mov_b32 m0, %0":"=&s"(keep):"v"(gsrc),"s"(lds_dst):"memory");}
__device__ __forceinline__ float max3f(float a,float b,float c){float r;asm("v_max3_f32 %0, %1, %2, %3":"=v"(r):"v"(a),"v"(b),"v"(c));return r;}
__device__ __forceinline__ float max2f(float a,float b){float r;asm("v_max_f32_e32 %0, %1, %2":"=v"(r):"v"(a),"v"(b));return r;}
__device__ __forceinline__ float fadd_s(float a,float b){float r;asm("v_add_f32_e32 %0, %1, %2":"=v"(r):"v"(a),"v"(b));return r;}
__device__ __forceinline__ float fsub_s(float a,float b){float r;asm("v_sub_f32_e32 %0, %1, %2":"=v"(r):"v"(a),"v"(b));return r;}
typedef float f32x2_t __attribute__((ext_vector_type(2))); typedef __bf16 bf16x2_t __attribute__((ext_vector_type(2)));
__device__ __forceinline__ unsigned cvtpk_s(float lo,float hi){f32x2_t v={lo,hi};bf16x2_t b=__builtin_convertvector(v,bf16x2_t);return __builtin_bit_cast(unsigned,b);}
#define WAIT_BAR(N) asm volatile("s_waitcnt vmcnt(" #N ") lgkmcnt(0)\n\ts_barrier":::"memory")

__device__ __forceinline__ void qkt(f32x16&p0,f32x16&p1,const char*Kslot,const bf16x8*qr,const f32x16&negm,int r32,int hi){
  const char*kb=Kslot+hi*1024+r32*16;
  #pragma unroll
  for(int d0=0;d0<4;++d0){
    const bf16x8 b0=*reinterpret_cast<const bf16x8*>(kb+d0*2048);
    const bf16x8 b1=*reinterpret_cast<const bf16x8*>(kb+d0*2048+512);
    if(d0==0){p0=__builtin_amdgcn_mfma_f32_32x32x16_bf16(b0,qr[0],negm,0,0,0);p1=__builtin_amdgcn_mfma_f32_32x32x16_bf16(b1,qr[0],negm,0,0,0);}
    else{p0=__builtin_amdgcn_mfma_f32_32x32x16_bf16(b0,qr[d0],p0,0,0,0);p1=__builtin_amdgcn_mfma_f32_32x32x16_bf16(b1,qr[d0],p1,0,0,0);}}
}
typedef __attribute__((address_space(3))) const char* lds_cptr;
typedef short v4i16_t __attribute__((ext_vector_type(4)));
__device__ __forceinline__ void kload8(bf16x8*kf,lds_cptr kp){
  kf[0]=*(const __attribute__((address_space(3))) bf16x8*)(kp);      kf[1]=*(const __attribute__((address_space(3))) bf16x8*)(kp+512);
  kf[2]=*(const __attribute__((address_space(3))) bf16x8*)(kp+2048); kf[3]=*(const __attribute__((address_space(3))) bf16x8*)(kp+2560);
  kf[4]=*(const __attribute__((address_space(3))) bf16x8*)(kp+4096); kf[5]=*(const __attribute__((address_space(3))) bf16x8*)(kp+4608);
  kf[6]=*(const __attribute__((address_space(3))) bf16x8*)(kp+6144); kf[7]=*(const __attribute__((address_space(3))) bf16x8*)(kp+6656);
}
__device__ __forceinline__ void kload2(bf16x8*kf,lds_cptr kp,int j){ kf[2*j]=*(const __attribute__((address_space(3))) bf16x8*)(kp+j*2048); kf[2*j+1]=*(const __attribute__((address_space(3))) bf16x8*)(kp+j*2048+512); }
__device__ __forceinline__ s16x4 vtr(lds_cptr p){ return __builtin_bit_cast(s16x4,__builtin_amdgcn_ds_read_tr16_b64_v4i16((__attribute__((address_space(3))) v4i16_t*)p)); }
__device__ __forceinline__ float rowmax(const f32x16&p0,const f32x16&p1){
  float a=max3f(p0[0],p0[1],p1[0]),b=max3f(p0[2],p0[3],p1[1]);a=max3f(a,p1[2],p1[3]);
  #pragma unroll
  for(int r=4;r<16;r+=4){a=max3f(a,p0[r],p0[r+1]);b=max3f(b,p0[r+2],p0[r+3]);a=max3f(a,p1[r],p1[r+1]);b=max3f(b,p1[r+2],p1[r+3]);}
  const float m=max2f(a,b);
  auto rr=__builtin_amdgcn_permlane32_swap(__float_as_uint(m),__float_as_uint(m),false,false);
  return max2f(__uint_as_float(rr[0]),__uint_as_float(rr[1]));
}
__device__ __forceinline__ void pv(f32x16*o,int vb,bf16x8 pa0,bf16x8 pa1,bf16x8 pa2,bf16x8 pa3){
  #pragma unroll
  for(int d0=0;d0<2;++d0){s16x4 lo[4],hi[4];
    #pragma unroll
    for(int ks=0;ks<4;++ks){
      asm volatile("ds_read_b64_tr_b16 %0,%1 offset:%c2":"=&v"(lo[ks]):"v"(vb),"i"(d0*4096+ks*1024):"memory");
      asm volatile("ds_read_b64_tr_b16 %0,%1 offset:%c2":"=&v"(hi[ks]):"v"(vb),"i"(d0*4096+ks*1024+512):"memory");}
    asm volatile("s_waitcnt lgkmcnt(0)":::"memory");SBAR();
    #define PK(k) (bf16x8){lo[k][0],lo[k][1],lo[k][2],lo[k][3],hi[k][0],hi[k][1],hi[k][2],hi[k][3]}
    o[d0]=__builtin_amdgcn_mfma_f32_32x32x16_bf16(pa0,PK(0),o[d0],0,0,0);
    o[d0]=__builtin_amdgcn_mfma_f32_32x32x16_bf16(pa1,PK(1),o[d0],0,0,0);
    o[d0]=__builtin_amdgcn_mfma_f32_32x32x16_bf16(pa2,PK(2),o[d0],0,0,0);
    o[d0]=__builtin_amdgcn_mfma_f32_32x32x16_bf16(pa3,PK(3),o[d0],0,0,0);
    #undef PK
  }
}

#ifndef ATTN_STORE16
#define ATTN_STORE16(p,v) (*(u32x4*)(p)=(v))
#endif
template<int THRL,int QP,int KP,int OP> __device__ __forceinline__ void attn_unit(const bf16*Qw,const bf16*__restrict__ Kh,const bf16*__restrict__ Vh,bf16*Ow,const int NT,char*shm,const int tid){
  const int lane=tid&63,r32=lane&31,hi=lane>>5; const int wid=__builtin_amdgcn_readfirstlane(tid>>6);
  const unsigned lds0=(unsigned)(uintptr_t)shm;
  float*wsf=(float*)(shm+LDS_WS)+wid*64;
  const bf16*ksrc=Kh+(long)lane*KP+wid*8;
  const bf16*vsrc=Vh+(long)(16*(wid&3)+(lane>>2))*KP+(wid>>2)*32+(lane&3)*8;
  const unsigned kdst=lds0+LDS_K+wid*1024, vdst=lds0+LDS_V+wid*1024;
  #define DMA_K(t,slot) glds16(ksrc+(long)(t)*KVBLK*KP,(unsigned)__builtin_amdgcn_readfirstlane(kdst+(slot)))
  #define DMA_V(t,slot) glds16(vsrc+(long)(t)*KVBLK*KP,(unsigned)__builtin_amdgcn_readfirstlane(vdst+(slot)))
  const int vb0=(int)(lds0+LDS_V)+((lane>>4)&1)*32+(lane&3)*8+(4*hi+((lane&15)>>2))*64;
  const char*Kbase=shm+LDS_K; bf16x8 kf[8];
  const lds_cptr shm3=(lds_cptr)shm; const lds_cptr kp0=shm3+LDS_K+hi*1024+r32*16; const lds_cptr vp0=shm3+LDS_V+((lane>>4)&1)*32+(lane&3)*8+(4*hi+((lane&15)>>2))*64;
  DMA_K(0,0);DMA_V(0,0);DMA_K(1,SLOTB);
  bf16x8 qr[4];
  #pragma unroll
  for(int d0=0;d0<4;++d0)qr[d0]=*reinterpret_cast<const bf16x8*>(&Qw[(long)r32*QP+d0*16+hi*8]);
  float mhat=0.f,l_reg=0.f;f32x16 o[2];o[0]=f32x16{};o[1]=f32x16{};f32x16 negm=f32x16{};asm volatile("":"+v"(negm));
  #define CMASK(P0,P1,t) do{}while(0)
  bool resc=false;
  #define START(P0,P1) do{ const float rm=rowmax(P0,P1); resc=false; \
    { const float dl=rm; mhat=fadd_s(mhat,dl); \
      _Pragma("unroll") for(int r=0;r<16;++r){P0[r]=fsub_s(P0[r],dl);P1[r]=fsub_s(P1[r],dl);} \
      _Pragma("unroll") for(int r=0;r<16;++r)negm[r]=-mhat; asm volatile("":"+v"(negm)); } \
    _Pragma("unroll") for(int r=0;r<16;++r)P0[r]=__builtin_amdgcn_exp2f(P0[r]); }while(0)
  #define RESC() do{ if(resc){ asm volatile("s_waitcnt lgkmcnt(0)":::"memory"); \
      _Pragma("unroll") for(int d_=0;d_<2;++d_) _Pragma("unroll") for(int r=0;r<16;++r)o[d_][r]*=wsf[crow(r,hi)]; } }while(0)
  f32x16 pA0,pA1,pB0,pB1;
  int sl_prev=0,sl_cur=0,sl_next=SLOTB;
  #define ROT() do{sl_prev=sl_cur;sl_cur=sl_next;sl_next=(sl_next==(NSLOT-1)*SLOTB)?0:sl_next+SLOTB;}while(0)
  DMA_K(2,2*SLOTB);
  WAIT_BAR(3);
  qkt(pA0,pA1,Kbase,qr,negm,r32,hi);asm volatile("s_nop 15\n\ts_nop 7":"+v"(pA0),"+v"(pA1));CMASK(pA0,pA1,0);
  START(pA0,pA1);
  _Pragma("unroll") for(int r=0;r<16;++r)pA1[r]=__builtin_amdgcn_exp2f(pA1[r]);
  WAIT_BAR(0);
  DMA_K(3,0);DMA_V(1,SLOTB);
  ROT();
  kload8(kf,kp0+sl_cur);
  WAIT_BAR(2);
  s16x4 vlo[8],vhi[8]; u32x4 pw0,pw1,pw2,pw3;
  #define PKW(P,B) cvtpk_s(P[B],P[B+1])
  #define PAF(k) __builtin_bit_cast(bf16x8,pw##k)
  #define VFR(i) (bf16x8){vlo[i][0],vlo[i][1],vlo[i][2],vlo[i][3],vhi[i][0],vhi[i][1],vhi[i][2],vhi[i][3]}
  #define PIN(x) asm volatile("":"+v"(x))
  #define MX3(a,b,c) __builtin_fmaxf(__builtin_fmaxf((a),(b)),(c))
  #define GAPA(MF,A0,A1,A2,A3,W0,W1,PW) do{ MF; sacc+=A0; sacc+=A1; sacc+=A2; sacc+=A3; PIN(sacc); W0; W1; PIN(PW); SBAR(); }while(0)
  #define EX(v) __builtin_amdgcn_exp2f(v)
  #define GAPB(MF,X,B) do{ MF; X[B]=EX(X[B]); X[B+1]=EX(X[B+1]); X[B+2]=EX(X[B+2]); X[B+3]=EX(X[B+3]); PIN(X); SBAR(); }while(0)
  #define VRD(i) do{ vlo[i]=vtr(vp_+(((i)>>2)*4096+((i)&3)*1024)); vhi[i]=vtr(vp_+(((i)>>2)*4096+((i)&3)*1024+512)); }while(0)
  #define KRD(G,j) do{ if(G){ kload2(kf,kp0+sl_next,j); SBAR(); } }while(0)
  #define STEP(C0,C1,P0,P1,t,GK,GV,GL) do{ SBAR(); \
    const lds_cptr vp_=vp0+sl_prev; \
    VRD(0); SBAR(); float sacc=(P0[0]+P0[1]); \
    GAPA(C0=__builtin_amdgcn_mfma_f32_32x32x16_bf16(kf[0],qr[0],negm,0,0,0), P0[2],P0[3],P0[4],P0[5],     pw0[0]=PKW(P0,0), pw0[1]=PKW(P0,2), pw0); \
    VRD(4); SBAR(); GAPA(C1=__builtin_amdgcn_mfma_f32_32x32x16_bf16(kf[1],qr[0],negm,0,0,0), P0[6],P0[7],P0[8],P0[9],     pw0[2]=PKW(P0,4), pw0[3]=PKW(P0,6), pw0); \
    VRD(1); SBAR(); GAPA(C0=__builtin_amdgcn_mfma_f32_32x32x16_bf16(kf[2],qr[1],C0,0,0,0),   P0[10],P0[11],P0[12],P0[13], pw1[0]=PKW(P0,8), pw1[1]=PKW(P0,10), pw1); \
    VRD(5); SBAR(); GAPA(C1=__builtin_amdgcn_mfma_f32_32x32x16_bf16(kf[3],qr[1],C1,0,0,0),   P0[14],P0[15],P1[0],P1[1],   pw1[2]=PKW(P0,12),pw1[3]=PKW(P0,14), pw1); \
    VRD(2); SBAR(); GAPA(C0=__builtin_amdgcn_mfma_f32_32x32x16_bf16(kf[4],qr[2],C0,0,0,0),   P1[2],P1[3],P1[4],P1[5],     pw2[0]=PKW(P1,0), pw2[1]=PKW(P1,2), pw2); \
    VRD(6); SBAR(); GAPA(C1=__builtin_amdgcn_mfma_f32_32x32x16_bf16(kf[5],qr[2],C1,0,0,0),   P1[6],P1[7],P1[8],P1[9],     pw2[2]=PKW(P1,4), pw2[3]=PKW(P1,6), pw2); \
    VRD(3); SBAR(); GAPA(C0=__builtin_amdgcn_mfma_f32_32x32x16_bf16(kf[6],qr[3],C0,0,0,0),   P1[10],P1[11],P1[12],P1[13], pw3[0]=PKW(P1,8), pw3[1]=PKW(P1,10), pw3); \
    VRD(7); SBAR(); GAPA(C1=__builtin_amdgcn_mfma_f32_32x32x16_bf16(kf[7],qr[3],C1,0,0,0),   P1[14],P1[15],0.f,0.f,       pw3[2]=PKW(P1,12),pw3[3]=PKW(P1,14), pw3); \
    l_reg+=sacc; \
    if(GK){DMA_K((t)+3,sl_cur);} if(GV){DMA_V((t)+1,sl_next);} \
    CMASK(C0,C1,t); \
    { float a=MX3(C0[0],C0[1],C1[0]),b=MX3(C0[2],C0[3],C1[1]); a=MX3(a,C1[2],C1[3]); \
      _Pragma("unroll") for(int r=4;r<16;r+=4){a=MX3(a,C0[r],C0[r+1]);b=MX3(b,C0[r+2],C0[r+3]);a=MX3(a,C1[r],C1[r+1]);b=MX3(b,C1[r+2],C1[r+3]);} \
      float rm=__builtin_fmaxf(a,b); { auto rr=__builtin_amdgcn_permlane32_swap(__float_as_uint(rm),__float_as_uint(rm),false,false); rm=__builtin_fmaxf(__uint_as_float(rr[0]),__uint_as_float(rr[1])); } \
      resc=false; \
      if(__builtin_expect(__any(rm>(float)THRL),0)){ const float dl=__builtin_fmaxf(rm,0.f); mhat+=dl; \
        _Pragma("unroll") for(int r=0;r<16;++r){C0[r]-=dl;C1[r]-=dl;} \
        _Pragma("unroll") for(int r=0;r<16;++r)negm[r]=-mhat; asm volatile("":"+v"(negm)); \
        const float f=__builtin_amdgcn_exp2f(-dl); l_reg*=f; if(hi==0)wsf[r32]=f; resc=true; } } \
    SBAR(); \
    GAPB(o[0]=__builtin_amdgcn_mfma_f32_32x32x16_bf16(PAF(0),VFR(0),o[0],0,0,0), C0,0); \
    GAPB(o[1]=__builtin_amdgcn_mfma_f32_32x32x16_bf16(PAF(0),VFR(4),o[1],0,0,0), C0,4); \
    KRD(GL,0); GAPB(o[0]=__builtin_amdgcn_mfma_f32_32x32x16_bf16(PAF(1),VFR(1),o[0],0,0,0), C0,8); \
    KRD(GL,1); GAPB(o[1]=__builtin_amdgcn_mfma_f32_32x32x16_bf16(PAF(1),VFR(5),o[1],0,0,0), C0,12); \
    KRD(GL,2); GAPB(o[0]=__builtin_amdgcn_mfma_f32_32x32x16_bf16(PAF(2),VFR(2),o[0],0,0,0), C1,0); \
    KRD(GL,3); GAPB(o[1]=__builtin_amdgcn_mfma_f32_32x32x16_bf16(PAF(2),VFR(6),o[1],0,0,0), C1,4); \
    GAPB(o[0]=__builtin_amdgcn_mfma_f32_32x32x16_bf16(PAF(3),VFR(3),o[0],0,0,0), C1,8); \
    GAPB(o[1]=__builtin_amdgcn_mfma_f32_32x32x16_bf16(PAF(3),VFR(7),o[1],0,0,0), C1,12); \
    }while(0)
  int t=1;
  #undef CMASK
  #define CMASK(P0,P1,t) do{}while(0)
  for(;t+5<NT;t+=2){
    STEP(pB0,pB1,pA0,pA1,t,true,true,true);     WAIT_BAR(2); RESC(); ROT();
    STEP(pA0,pA1,pB0,pB1,t+1,true,true,true);   WAIT_BAR(2); RESC(); ROT();
  }
  #undef CMASK
  #define CMASK(P0,P1,t) do{}while(0)
  #define ENDW(tt) do{ if((tt)+3<NT){WAIT_BAR(2);} else if((tt)+2<NT){WAIT_BAR(1);} else {WAIT_BAR(0);} }while(0)
  for(;t+1<NT;t+=2){
    STEP(pB0,pB1,pA0,pA1,t,(t+3<NT),(t+1<NT),(t+1<NT));       ENDW(t);   RESC(); ROT();
    STEP(pA0,pA1,pB0,pB1,t+1,(t+4<NT),(t+2<NT),(t+2<NT));     ENDW(t+1); RESC(); ROT();
  }
  STEP(pB0,pB1,pA0,pA1,NT-1,false,false,false); RESC();
  { float sacc=pB0[0]+pB0[1]; _Pragma("unroll") for(int r=2;r<16;++r)sacc+=pB0[r]; _Pragma("unroll") for(int r=0;r<16;++r)sacc+=pB1[r]; l_reg+=sacc;
    pw0=(u32x4){PKW(pB0,0),PKW(pB0,2),PKW(pB0,4),PKW(pB0,6)};pw1=(u32x4){PKW(pB0,8),PKW(pB0,10),PKW(pB0,12),PKW(pB0,14)};pw2=(u32x4){PKW(pB1,0),PKW(pB1,2),PKW(pB1,4),PKW(pB1,6)};pw3=(u32x4){PKW(pB1,8),PKW(pB1,10),PKW(pB1,12),PKW(pB1,14)};
    SBAR(); pv(o,vb0+sl_cur,PAF(0),PAF(1),PAF(2),PAF(3)); }
  #undef PKW
  #undef PAF
  #undef VFR
  #undef PIN
  #undef MX3
  #undef GAPA
  #undef GAPB
  #undef EX
  #undef VRD
  #undef KRD
  #undef STEP
  #undef ENDW
  {auto rr=__builtin_amdgcn_permlane32_swap(__float_as_uint(l_reg),__float_as_uint(l_reg),false,false);l_reg=__uint_as_float(rr[0])+__uint_as_float(rr[1]);}
  if(hi==0)wsf[32+r32]=l_reg;asm volatile("s_waitcnt lgkmcnt(0)":::"memory");
  float rli[16];
  #pragma unroll
  for(int r=0;r<16;++r)rli[r]=__builtin_amdgcn_rcpf(wsf[32+crow(r,hi)]);
  { bf16*stg=(bf16*)(shm+LDS_OST)+wid*2048;
    #pragma unroll
    for(int r=0;r<16;++r){const int orow=crow(r,hi);
      #pragma unroll
      for(int d0=0;d0<2;++d0)stg[orow*64+d0*32+r32]=(bf16)f2bf_dev(o[d0][r]*rli[r]);}
    asm volatile("s_waitcnt lgkmcnt(0)":::"memory");
    #pragma unroll
    for(int i=0;i<4;++i){const int row=i*8+(lane>>3),ch=lane&7; const u32x4 v=*(const u32x4*)(stg+row*64+ch*8); ATTN_STORE16(Ow+(long)row*OP+ch*8,v);} }
  asm volatile("s_waitcnt lgkmcnt(0)\n\ts_barrier":::"memory");
  #undef DMA_K
  #undef DMA_V
  #undef CMASK
  #undef START
  #undef RESC
  #undef ROT
}
constexpr int ATTN_LDS_BYTES=LDS_BYTES;
}

constexpr int SEQ = 16384, BATCH = 2, MTOK = BATCH * SEQ, DM = 1024, DEPTH = 4;
constexpr int NQH = 12, NKVH = 3, NMH = 4, NMEM = 256;
constexpr int QW = 768, KVW = 192, QMW = 256, INW = 1408, INWP = 1536, DFF = 2816, GUW = 5632;
constexpr float EPS = 1e-6f;
constexpr float QSCALE = 0.125f * 1.4426950408889634f;

typedef unsigned short bf16_t;
typedef short bf16x8 __attribute__((ext_vector_type(8)));
typedef float f32x4 __attribute__((ext_vector_type(4)));
typedef float f32x16 __attribute__((ext_vector_type(16)));
typedef unsigned u32x4 __attribute__((ext_vector_type(4)));
typedef unsigned u32x2 __attribute__((ext_vector_type(2)));
#define LAS __attribute__((address_space(3)))

constexpr size_t MiB = 1u << 20;
constexpr size_t WS_TAB = 0;
constexpr size_t WS_MEMN = 2 * MiB;
constexpr size_t WS_KVM = 3 * MiB;
constexpr size_t WS_LSE = 5 * MiB;
constexpr size_t WS_RS = 7 * MiB + 65536;
constexpr size_t WS_CTL = 7 * MiB, CTL_BYTES = 16384;
constexpr size_t WS_W = 8 * MiB;
constexpr size_t W_LAYER = 23 * MiB, WO_IN = 0, WO_O = 3 * MiB, WO_GU = 5 * MiB, WO_D = 16 * MiB;
constexpr size_t WS_WKV = WS_W + 4 * W_LAYER;
constexpr size_t WS_HB = 104 * MiB;
constexpr size_t WS_OB = 168 * MiB;
constexpr size_t WS_R1 = 232 * MiB;
constexpr size_t WS_Q = WS_R1, WS_K = WS_Q + 48 * MiB, WS_V = WS_K + 12 * MiB, WS_QM = WS_V + 12 * MiB, WS_CTX = WS_QM + 16 * MiB;
constexpr size_t WS_END = WS_R1 + 176 * MiB;

struct Params {
    const float* x; const float* mem; const float* mem_g; const float* w_in; const float* w_kv; const float* w_o;
    const float* g_mix_pre; const float* g_mix_post; const float* sink; const float* qk_g;
    const float* w_gu; const float* w_d; const float* g_ffn_pre; const float* g_ffn_post;
    float* out; unsigned char* ws;
    float invp[8]; float inva[16];
    int ph_lo, ph_hi;
};

__device__ __forceinline__ unsigned f2bf(float f) { unsigned u = __builtin_bit_cast(unsigned, f); return (u + 0x7fffu + ((u >> 16) & 1u)) >> 16; }
__device__ __forceinline__ unsigned pk2(float lo, float hi) { return pg8::cvt_pk_bf16(lo, hi); }
__device__ __forceinline__ float bflo(unsigned w) { return __builtin_bit_cast(float, w << 16); }
__device__ __forceinline__ float bfhi(unsigned w) { return __builtin_bit_cast(float, w & 0xffff0000u); }
__device__ __forceinline__ float wave_sum(float v) {
#pragma unroll
    for (int o = 1; o < 64; o <<= 1) v += __shfl_xor(v, o);
    return v;
}

struct EpiPlain {
    static constexpr bool PERM = true, AFTER_DRAIN = false;
    bf16_t* O; int ldc;
    __device__ __forceinline__ void operator()(const f32x4 (&acc)[2][2][4][2], const pg8::Unit& u, int wr, int wc, int fr, int fq) const {
        const int row0 = u.pm * 256 + wr * 64 + fr, col0 = u.pn * 256 + wc * 32 + 8 * fq;
#pragma unroll
        for (int ai = 0; ai < 2; ++ai)
#pragma unroll
            for (int m = 0; m < 4; ++m) { bf16_t* rowp = O + (size_t)(row0 + ai * 128 + m * 16) * ldc + col0;
#pragma unroll
                for (int bj = 0; bj < 2; ++bj) { const f32x4 v0 = acc[ai][bj][m][0], v1 = acc[ai][bj][m][1];
                    u32x4 w; w.x = pk2(v0[0], v0[1]); w.y = pk2(v0[2], v0[3]); w.z = pk2(v1[0], v1[1]); w.w = pk2(v1[2], v1[3]);
                    *(u32x4*)(rowp + bj * 128) = w; } }
    }
};
struct EpiSwiGLU {
    static constexpr bool PERM = true, AFTER_DRAIN = false;
    bf16_t* O; int ldc; const float* rs;
    __device__ __forceinline__ void operator()(const f32x4 (&acc)[2][2][4][2], const pg8::Unit& u, int wr, int wc, int fr, int fq) const {
        const int row0 = u.pm * 256 + wr * 64 + fr, col0 = u.pn * 128 + wc * 32 + 8 * fq;
#pragma unroll
        for (int ai = 0; ai < 2; ++ai)
#pragma unroll
            for (int m = 0; m < 4; ++m) { bf16_t* rowp = O + (size_t)(row0 + ai * 128 + m * 16) * ldc + col0; const float rr = rs[row0 + ai * 128 + m * 16];
                float r[8];
#pragma unroll
                for (int n = 0; n < 2; ++n)
#pragma unroll
                    for (int j = 0; j < 4; ++j) { const float g = acc[ai][0][m][n][j] * rr, up = acc[ai][1][m][n][j] * rr;
                        const float s = __builtin_amdgcn_rcpf(1.0f + __builtin_amdgcn_exp2f(-1.4426950408889634f * g));
                        r[n * 4 + j] = g * s * up; }
                u32x4 w; w.x = pk2(r[0], r[1]); w.y = pk2(r[2], r[3]); w.z = pk2(r[4], r[5]); w.w = pk2(r[6], r[7]);
                *(u32x4*)rowp = w; }
    }
};
struct EpiIn {
    static constexpr bool PERM = true, AFTER_DRAIN = false;
    bf16_t *Q, *K, *V, *QM; int kind;
    const float *cosp, *sinp, *cosa, *sina; const float* qkg; const float* rs;
    __device__ __forceinline__ void operator()(const f32x4 (&acc)[2][2][4][2], const pg8::Unit& u, int wr, int wc, int fr, int fq) const {
        const int vh = 4 * u.pn + wc; if (vh >= 22) return;
        const int row0 = u.pm * 256 + wr * 64 + fr;
        const bool isq = vh < 12, isk = vh >= 12 && vh < 15, isv = vh >= 15 && vh < 18;
        bf16_t* base; int ld;
        if (isq) { base = Q + vh * 64; ld = QW; } else if (isk) { base = K + (vh - 12) * 64; ld = KVW; } else if (isv) { base = V + (vh - 15) * 64; ld = KVW; } else { base = QM + (vh - 18) * 64; ld = QMW; }
        const float osc = (isq || (!isk && !isv)) ? QSCALE : 1.0f;
#pragma unroll
        for (int ai = 0; ai < 2; ++ai)
#pragma unroll
            for (int m = 0; m < 4; ++m) {
                const int row = row0 + ai * 128 + m * 16, t = row & (SEQ - 1); const float rr = rs[row];
                float v[2][8];
#pragma unroll
                for (int bj = 0; bj < 2; ++bj)
#pragma unroll
                    for (int n = 0; n < 2; ++n)
#pragma unroll
                        for (int j = 0; j < 4; ++j) v[bj][n * 4 + j] = acc[ai][bj][m][n][j] * rr;
                if (isq || isk) {
                    if (kind == 1) {
                        float ss = 0.f;
#pragma unroll
                        for (int bj = 0; bj < 2; ++bj)
#pragma unroll
                            for (int e = 0; e < 8; ++e) ss += v[bj][e] * v[bj][e];
                        ss += __shfl_xor(ss, 16); ss += __shfl_xor(ss, 32);
                        const float rs = 1.0f / sqrtf(ss * (1.0f / 64.0f) + EPS);
                        const float* gp = qkg + (isk ? 64 : 0) + 8 * fq;
#pragma unroll
                        for (int bj = 0; bj < 2; ++bj) { const f32x4 g0 = *(const f32x4*)(gp + 32 * bj), g1 = *(const f32x4*)(gp + 32 * bj + 4);
#pragma unroll
                            for (int e = 0; e < 4; ++e) { v[bj][e] *= rs * g0[e]; v[bj][4 + e] *= rs * g1[e]; } }
#pragma unroll
                        for (int bj = 0; bj < 2; ++bj) {
                            const int ti = (bj == 0 ? (t >> 6) : (t & 63)) * 16 + 8 * (fq & 1);
                            const f32x4 c0 = *(const f32x4*)(cosa + ti), c1 = *(const f32x4*)(cosa + ti + 4), s0 = *(const f32x4*)(sina + ti), s1 = *(const f32x4*)(sina + ti + 4);
#pragma unroll
                            for (int e = 0; e < 8; ++e) { const float pr = __shfl_xor(v[bj][e], 32); const float c = e < 4 ? c0[e & 3] : c1[e & 3], s = e < 4 ? s0[e & 3] : s1[e & 3];
                                v[bj][e] = v[bj][e] * c + (fq < 2 ? -pr : pr) * s; }
                        }
                    } else {
                        const f32x4 c0 = *(const f32x4*)(cosp + t * 8), c1 = *(const f32x4*)(cosp + t * 8 + 4), s0 = *(const f32x4*)(sinp + t * 8), s1 = *(const f32x4*)(sinp + t * 8 + 4);
#pragma unroll
                        for (int e = 0; e < 8; ++e) { const float pr = __shfl_xor(v[0][e], 16); const float c = e < 4 ? c0[e & 3] : c1[e & 3], s = e < 4 ? s0[e & 3] : s1[e & 3];
                            const float rv = v[0][e] * c + (fq == 0 ? -pr : pr) * s; v[0][e] = fq < 2 ? rv : v[0][e]; }
                    }
                }
                bf16_t* rowp = base + (size_t)row * ld + 8 * fq;
#pragma unroll
                for (int bj = 0; bj < 2; ++bj) { u32x4 w; w.x = pk2(v[bj][0] * osc, v[bj][1] * osc); w.y = pk2(v[bj][2] * osc, v[bj][3] * osc); w.z = pk2(v[bj][4] * osc, v[bj][5] * osc); w.w = pk2(v[bj][6] * osc, v[bj][7] * osc);
                    *(u32x4*)(rowp + 32 * bj) = w; }
            }
    }
};

__device__ __forceinline__ void transpose_item(const float* W, int K, int ldw, bf16_t* WT, int dst_row0, int src_col0, const float* gk, LAS float* scr, int kb, int lane) {
    const int k0 = 64 * kb;
#pragma unroll 8
    for (int i = 0; i < 32; ++i) { const int kk = 2 * i + (lane >> 5); float val = 0.f;
        if (src_col0 >= 0) { val = W[(size_t)(k0 + kk) * ldw + src_col0 + (lane & 31)]; if (gk) val *= gk[k0 + kk]; }
        scr[kk * 33 + (lane & 31)] = val; }
    asm volatile("s_waitcnt lgkmcnt(0)" ::: "memory");
    const int c = lane & 7;
#pragma unroll
    for (int j = 0; j < 4; ++j) { const int n = (lane >> 3) + 8 * j; const LAS float* s = scr + (8 * c) * 33 + n;
        u32x4 o; o.x = pk2(s[0 * 33], s[1 * 33]); o.y = pk2(s[2 * 33], s[3 * 33]); o.z = pk2(s[4 * 33], s[5 * 33]); o.w = pk2(s[6 * 33], s[7 * 33]);
        *(u32x4*)(WT + (size_t)(dst_row0 + n) * K + k0 + 8 * c) = o; }
    asm volatile("s_waitcnt lgkmcnt(0)" ::: "memory");
}
__device__ __forceinline__ void row_pass(const bf16_t* ob, const float* g, const float* xf, bf16_t* xb, float* rsp, float* xout, bf16_t* hb_norm, const float* g2, int lane) {
    f32x4 x[4];
    if (xf) {
#pragma unroll
        for (int j = 0; j < 4; ++j) x[j] = *(const f32x4*)(xf + 4 * lane + 256 * j);
    } else {
#pragma unroll
        for (int j = 0; j < 4; ++j) { const u32x2 w = *(const u32x2*)(xb + 4 * lane + 256 * j); x[j] = (f32x4){bflo(w.x), bfhi(w.x), bflo(w.y), bfhi(w.y)}; }
    }
    if (ob) {
        f32x4 o[4]; float ss = 0.f;
#pragma unroll
        for (int j = 0; j < 4; ++j) { const u32x2 w = *(const u32x2*)(ob + 4 * lane + 256 * j); o[j] = (f32x4){bflo(w.x), bfhi(w.x), bflo(w.y), bfhi(w.y)};
            ss += (o[j][0] * o[j][0] + o[j][1] * o[j][1]) + (o[j][2] * o[j][2] + o[j][3] * o[j][3]); }
        const float rs = 1.0f / sqrtf(wave_sum(ss) * (1.0f / DM) + EPS);
#pragma unroll
        for (int j = 0; j < 4; ++j) { const f32x4 gv = *(const f32x4*)(g + 4 * lane + 256 * j); x[j] = x[j] + o[j] * rs * gv; }
    }
    if (xout) {
#pragma unroll
        for (int j = 0; j < 4; ++j) *(f32x4*)(xout + 4 * lane + 256 * j) = x[j];
        return;
    }
    float ss = 0.f;
#pragma unroll
    for (int j = 0; j < 4; ++j) ss += (x[j][0] * x[j][0] + x[j][1] * x[j][1]) + (x[j][2] * x[j][2] + x[j][3] * x[j][3]);
    const float rs = 1.0f / sqrtf(wave_sum(ss) * (1.0f / DM) + EPS);
    if (hb_norm) {
#pragma unroll
        for (int j = 0; j < 4; ++j) { const f32x4 y = x[j] * rs * *(const f32x4*)(g2 + 4 * lane + 256 * j);
            u32x2 w; w.x = pk2(y[0], y[1]); w.y = pk2(y[2], y[3]); *(u32x2*)(hb_norm + 4 * lane + 256 * j) = w; }
        return;
    }
#pragma unroll
    for (int j = 0; j < 4; ++j) { u32x2 w; w.x = pk2(x[j][0], x[j][1]); w.y = pk2(x[j][2], x[j][3]); *(u32x2*)(xb + 4 * lane + 256 * j) = w; }
    if (lane == 0) *rsp = rs;
}

constexpr int AT_PITCH = 72, AT_TILE_B = 64 * AT_PITCH * 2, AT_K = 0, AT_V = 2 * AT_TILE_B;
__device__ __forceinline__ int crow(int r, int hi) { return (r & 3) + 8 * (r >> 2) + 4 * hi; }
__device__ __forceinline__ void attn_unit(LAS unsigned char* lds, const bf16_t* Qp, int qpitch, long qrowbase, int qstride, int iq,
                                          const bf16_t* Kp, const bf16_t* Vp, int kpitch, long krowbase, int kstride,
                                          int t_lo, int t_hi, int R, int q0blk,
                                          bf16_t* Op, int opitch, float* lsep, float sink_l2, bool has_sink, const int tid) {
    const int lane = tid & 63, r32 = lane & 31, hi = lane >> 5, wid = __builtin_amdgcn_readfirstlane(tid >> 6);
    const long qrow = qrowbase + (long)iq * qstride;
    bf16x8 qr[4];
#pragma unroll
    for (int d0 = 0; d0 < 4; ++d0) qr[d0] = *(const bf16x8*)(Qp + qrow * qpitch + d0 * 16 + hi * 8);
    float mrun = -1e30f, lrun = 0.f; f32x16 o[2];
#pragma unroll
    for (int r = 0; r < 16; ++r) { o[0][r] = 0.f; o[1][r] = 0.f; }
    const int vpos = (lane & ~15) + 8 * ((lane >> 2) & 1) + (lane & 3) + 4 * ((lane >> 3) & 1);
    u32x4 kreg, vreg;
    { const long kr = krowbase + (long)(t_lo * 64 + lane) * kstride; kreg = *(const u32x4*)(Kp + kr * kpitch + wid * 8); vreg = *(const u32x4*)(Vp + kr * kpitch + wid * 8); }
    for (int t = t_lo; t < t_hi; ++t) {
        const int buf = (t - t_lo) & 1;
        LAS unsigned char* ks = lds + AT_K + buf * AT_TILE_B; LAS unsigned char* vt = lds + AT_V + buf * AT_TILE_B;
        *(LAS u32x4*)(ks + lane * (AT_PITCH * 2) + wid * 16) = kreg;
        { LAS bf16_t* vb = (LAS bf16_t*)vt + (wid * 8) * AT_PITCH + vpos;
          vb[0 * AT_PITCH] = (bf16_t)(vreg.x & 0xffff); vb[1 * AT_PITCH] = (bf16_t)(vreg.x >> 16); vb[2 * AT_PITCH] = (bf16_t)(vreg.y & 0xffff); vb[3 * AT_PITCH] = (bf16_t)(vreg.y >> 16);
          vb[4 * AT_PITCH] = (bf16_t)(vreg.z & 0xffff); vb[5 * AT_PITCH] = (bf16_t)(vreg.z >> 16); vb[6 * AT_PITCH] = (bf16_t)(vreg.w & 0xffff); vb[7 * AT_PITCH] = (bf16_t)(vreg.w >> 16); }
        __syncthreads();
        if (t + 1 < t_hi) { const long kr = krowbase + (long)((t + 1) * 64 + lane) * kstride; kreg = *(const u32x4*)(Kp + kr * kpitch + wid * 8); vreg = *(const u32x4*)(Vp + kr * kpitch + wid * 8); }
        f32x16 p0, p1;
#pragma unroll
        for (int r = 0; r < 16; ++r) { p0[r] = 0.f; p1[r] = 0.f; }
#pragma unroll
        for (int d0 = 0; d0 < 4; ++d0) {
            const bf16x8 b0 = *(const LAS bf16x8*)(ks + r32 * (AT_PITCH * 2) + d0 * 32 + hi * 16);
            const bf16x8 b1 = *(const LAS bf16x8*)(ks + (32 + r32) * (AT_PITCH * 2) + d0 * 32 + hi * 16);
            p0 = __builtin_amdgcn_mfma_f32_32x32x16_bf16(b0, qr[d0], p0, 0, 0, 0);
            p1 = __builtin_amdgcn_mfma_f32_32x32x16_bf16(b1, qr[d0], p1, 0, 0, 0);
        }
        { const int dmax1 = q0blk + 63 - 64 * t, dmax2 = 64 * t + 63 - q0blk;
          if (dmax1 > R || dmax2 > R) {
#pragma unroll
              for (int r = 0; r < 16; ++r) { const int kv = 64 * t + crow(r, hi); int d = kv - iq; d = d < 0 ? -d : d; if (d > R) p0[r] = -1e30f; int d2 = kv + 32 - iq; d2 = d2 < 0 ? -d2 : d2; if (d2 > R) p1[r] = -1e30f; }
          } }
        float mt = fmaxf(p0[0], p1[0]);
#pragma unroll
        for (int r = 1; r < 16; ++r) mt = fmaxf(mt, fmaxf(p0[r], p1[r]));
        mt = fmaxf(mt, __shfl_xor(mt, 32));
        const float mnew = fmaxf(mrun, mt), alpha = __builtin_amdgcn_exp2f(mrun - mnew); mrun = mnew;
        float sum = 0.f;
#pragma unroll
        for (int r = 0; r < 16; ++r) { p0[r] = __builtin_amdgcn_exp2f(p0[r] - mnew); p1[r] = __builtin_amdgcn_exp2f(p1[r] - mnew); sum += p0[r] + p1[r]; }
        lrun = lrun * alpha + sum;
#pragma unroll
        for (int r = 0; r < 16; ++r) { o[0][r] *= alpha; o[1][r] *= alpha; }
        u32x4 pw[4];
        pw[0] = (u32x4){pk2(p0[0], p0[1]), pk2(p0[2], p0[3]), pk2(p0[4], p0[5]), pk2(p0[6], p0[7])};
        pw[1] = (u32x4){pk2(p0[8], p0[9]), pk2(p0[10], p0[11]), pk2(p0[12], p0[13]), pk2(p0[14], p0[15])};
        pw[2] = (u32x4){pk2(p1[0], p1[1]), pk2(p1[2], p1[3]), pk2(p1[4], p1[5]), pk2(p1[6], p1[7])};
        pw[3] = (u32x4){pk2(p1[8], p1[9]), pk2(p1[10], p1[11]), pk2(p1[12], p1[13]), pk2(p1[14], p1[15])};
#pragma unroll
        for (int d0 = 0; d0 < 2; ++d0)
#pragma unroll
            for (int ksx = 0; ksx < 4; ++ksx) {
                const bf16x8 vf = *(const LAS bf16x8*)(vt + (32 * d0 + r32) * (AT_PITCH * 2) + ksx * 32 + hi * 16);
                o[d0] = __builtin_amdgcn_mfma_f32_32x32x16_bf16(vf, __builtin_bit_cast(bf16x8, pw[ksx]), o[d0], 0, 0, 0);
            }
    }
    lrun += __shfl_xor(lrun, 32);
    if (has_sink) lrun += __builtin_amdgcn_exp2f(sink_l2 - mrun);
    const float inv = 1.0f / lrun;
    bf16_t* orow = Op + qrow * opitch;
#pragma unroll
    for (int d0 = 0; d0 < 2; ++d0)
#pragma unroll
        for (int rq = 0; rq < 4; ++rq) { u32x2 w; w.x = pk2(o[d0][4 * rq] * inv, o[d0][4 * rq + 1] * inv); w.y = pk2(o[d0][4 * rq + 2] * inv, o[d0][4 * rq + 3] * inv);
            *(u32x2*)(orow + 32 * d0 + 8 * rq + 4 * hi) = w; }
    if (lsep && hi == 0) lsep[qrow * 12] = mrun + __builtin_log2f(lrun);
    __syncthreads();
}
#define XB_TMO      128
#define XB_XCNT(j)  (256  + 64 * (j))
#define XB_XSUB(j)  (1280 + 64 * (j))
#define XB_XGEN(j)  (2304 + 64 * (j))
#define XB_TOP      3328
#define XB_TOPGEN   3392
#define XCD_BAR_WORDS 3456
#define XB_SPIN_CAP (1u << 18)

__device__ __forceinline__ unsigned xb_ld(unsigned* p)              { return __hip_atomic_load(p, __ATOMIC_RELAXED, __HIP_MEMORY_SCOPE_AGENT); }
__device__ __forceinline__ unsigned xb_add(unsigned* p, unsigned v) { return __hip_atomic_fetch_add(p, v, __ATOMIC_RELAXED, __HIP_MEMORY_SCOPE_AGENT); }
__device__ __forceinline__ unsigned xb_xcc_id() { return (unsigned)__builtin_amdgcn_s_getreg((3 << 11) | 20) & 0xFu; }
#define XB_SPIN(cond, bar) do { unsigned _sp = 0; while (cond) { __builtin_amdgcn_s_sleep(1); \
    if ((++_sp & 255u) == 0u) { if (xb_ld(&(bar)[XB_TMO])) break; if (_sp > XB_SPIN_CAP) { atomicAdd(&(bar)[XB_TMO], 1u); break; } } } } while (0)

struct XcdBarrier {
    unsigned* bar; unsigned x;
    volatile LAS unsigned* st;
};

__device__ __forceinline__ XcdBarrier xcd_barrier_post(unsigned* bar, volatile LAS unsigned* st) {
    XcdBarrier b; b.bar = bar; b.x = xb_xcc_id(); b.st = st;
    if (threadIdx.x == 0) (void)xb_add(&bar[XB_XCNT(b.x)], 1u);
    return b;
}
__device__ __forceinline__ void xcd_barrier_complete(unsigned* bar, unsigned x, unsigned& nloc, unsigned& nx) {
    const unsigned G = gridDim.x * gridDim.y * gridDim.z;
    unsigned sum, cnt, mine, sp = 0u;
    for (;;) {
        sum = 0u; cnt = 0u; mine = 0u;
#pragma unroll
        for (unsigned j = 0; j < 16; ++j) { const unsigned c = xb_ld(&bar[XB_XCNT(j)]); sum += c; cnt += (c > 0u) ? 1u : 0u; mine = (j == x) ? c : mine; }
        if (sum == G) break;
        __builtin_amdgcn_s_sleep(1);
        if ((++sp & 255u) == 0u) { if (xb_ld(&bar[XB_TMO])) break; if (sp > XB_SPIN_CAP) { atomicAdd(&bar[XB_TMO], 1u); break; } }
    }
    nloc = mine > 0u ? mine : 1u; nx = cnt > 0u ? cnt : 1u;
}

__device__ __forceinline__ void xcd_barrier(const XcdBarrier& b) {
    asm volatile("s_waitcnt vmcnt(0)" ::: "memory");
    __syncthreads();
    if (threadIdx.x == 0) {
        unsigned* bar = b.bar;
        __builtin_amdgcn_s_waitcnt(0);
        unsigned nloc = b.st[0], nx = b.st[1];
        if (nloc == 0u) { xcd_barrier_complete(bar, b.x, nloc, nx); b.st[0] = nloc; b.st[1] = nx; }
        const unsigned old = xb_add(&bar[XB_XSUB(b.x)], 1u);
        const unsigned gen = old / nloc;
        if (old + 1u == (gen + 1u) * nloc) {
            __builtin_amdgcn_fence(__ATOMIC_RELEASE, "agent");
            asm volatile("s_waitcnt vmcnt(0)" ::: "memory");
            const unsigned og = xb_add(&bar[XB_TOP], 1u);
            const unsigned tg = og / nx;
            if (og + 1u == (tg + 1u) * nx) xb_add(&bar[XB_TOPGEN], 1u);
            else XB_SPIN(xb_ld(&bar[XB_TOPGEN]) == tg, bar);
            __builtin_amdgcn_fence(__ATOMIC_ACQUIRE, "agent");
            xb_add(&bar[XB_XGEN(b.x)], 1u);
            asm volatile("s_waitcnt vmcnt(0)" ::: "memory");
        } else {
            XB_SPIN(xb_ld(&bar[XB_XGEN(b.x)]) == gen, bar);
            __builtin_amdgcn_fence(__ATOMIC_ACQUIRE, "agent");
            asm volatile("s_waitcnt vmcnt(0)" ::: "memory");
        }
    }
    __syncthreads();
}

constexpr int LDS_BYTES = 131072 + 1024;
constexpr int NPHASES = 1 + 4 * 7 + 1;
#ifndef PROBE_ATT_L
#define PROBE_ATT_L -1
#endif

__device__ __forceinline__ float lse_weight(const float* L, int head) {
    const int j = head & 3; const float a = L[j], b = L[4 + j], c = L[8 + j], mine = L[head];
    const float m = fmaxf(a, fmaxf(b, c));
    const float s = __builtin_amdgcn_exp2f(a - m) + __builtin_amdgcn_exp2f(b - m) + __builtin_amdgcn_exp2f(c - m);
    return __builtin_amdgcn_exp2f(mine - m) / s;
}

__global__ void __launch_bounds__(512, 2) fwd_megakernel(Params p) {
    extern __shared__ __attribute__((aligned(16))) unsigned char lds_raw[];
    LAS unsigned char* lds = (LAS unsigned char*)lds_raw;
    cg::grid_group grid = cg::this_grid();
    const int tid = threadIdx.x, wid = __builtin_amdgcn_readfirstlane(tid >> 6);
    const int G = gridDim.x, gw = blockIdx.x * 8 + wid, NGW = G * 8;
    unsigned char* ws = p.ws;
    float* cosp = (float*)(ws + WS_TAB); float* sinp = cosp + SEQ * 8; float* cosa = sinp + SEQ * 8; float* sina = cosa + 256 * 16;
    bf16_t* MEMN = (bf16_t*)(ws + WS_MEMN); bf16_t* KVM = (bf16_t*)(ws + WS_KVM); float* LSE = (float*)(ws + WS_LSE);
    bf16_t* WKV = (bf16_t*)(ws + WS_WKV); bf16_t* HB = (bf16_t*)(ws + WS_HB); bf16_t* OB = (bf16_t*)(ws + WS_OB);
    bf16_t* Qb = (bf16_t*)(ws + WS_Q); bf16_t* Kb = (bf16_t*)(ws + WS_K); bf16_t* Vb = (bf16_t*)(ws + WS_V); bf16_t* QMb = (bf16_t*)(ws + WS_QM);
    bf16_t* CTX = (bf16_t*)(ws + WS_CTX); bf16_t* ACT = (bf16_t*)(ws + WS_R1); float* RS = (float*)(ws + WS_RS);
    LAS unsigned* MISC = (LAS unsigned*)(lds + 131072);
    if (tid < 64) MISC[tid] = 0u;
    __syncthreads();
    const XcdBarrier bar = xcd_barrier_post((unsigned*)(ws + WS_CTL), (volatile LAS unsigned*)(MISC + 8));
    int ph = 0;
#define PH_ON (ph >= p.ph_lo && ph < p.ph_hi)
#define LAUNDER int tl_ = tid; asm volatile("" : "+v"(tl_)); const int lane = tl_ & 63; (void)lane
#define PH_END do { if (PH_ON && ph + 1 < p.ph_hi) { if (ph == 0) grid.sync(); else xcd_barrier(bar); } ++ph; } while (0)

    if (PH_ON) { LAUNDER;
        LAS float* scr = (LAS float*)(lds + wid * 16384);
        constexpr int I_IN = 16 * 48, I_O = 16 * 32, I_GU = 16 * 176, I_D = 44 * 32, I_KV = 16 * 16, I_L = I_IN + I_O + I_GU + I_D + I_KV;
        for (int it = gw; it < DEPTH * I_L; it += NGW) {
            const int l = it / I_L; int r = it % I_L;
            bf16_t* wl = (bf16_t*)(ws + WS_W + (size_t)l * W_LAYER);
            if (r < I_IN) { const int kb = r / 48, nb = r % 48, R0 = 32 * nb, tile = R0 >> 8, c = R0 & 255, vh = 4 * tile + ((c >> 5) & 3), src = vh < 22 ? 64 * vh + 32 * (c >> 7) : -1;
                transpose_item(p.w_in + (size_t)l * DM * INW, DM, INW, (bf16_t*)((unsigned char*)wl + WO_IN), R0, src, p.g_mix_pre + l * DM, scr, kb, lane); continue; }
            r -= I_IN;
            if (r < I_O) { const int kb = r / 32, nb = r % 32;
                transpose_item(p.w_o + (size_t)l * DM * DM, DM, DM, (bf16_t*)((unsigned char*)wl + WO_O), 32 * nb, 32 * nb, nullptr, scr, kb, lane); continue; }
            r -= I_O;
            if (r < I_GU) { const int kb = r / 176, nb = r % 176, R0 = 32 * nb, tile = R0 >> 8, c = R0 & 255, src = ((c >> 7) ? DFF : 0) + 128 * tile + (c & 127);
                transpose_item(p.w_gu + (size_t)l * DM * GUW, DM, GUW, (bf16_t*)((unsigned char*)wl + WO_GU), R0, src, p.g_ffn_pre + l * DM, scr, kb, lane); continue; }
            r -= I_GU;
            if (r < I_D) { const int kb = r / 32, nb = r % 32;
                transpose_item(p.w_d + (size_t)l * DFF * DM, DFF, DM, (bf16_t*)((unsigned char*)wl + WO_D), 32 * nb, 32 * nb, nullptr, scr, kb, lane); continue; }
            r -= I_D;
            { const int kb = r / 16, nb = r % 16;
                transpose_item(p.w_kv + (size_t)l * DM * 512, DM, 512, WKV + (size_t)l * 512 * DM, 32 * nb, 32 * nb, nullptr, scr, kb, lane); }
        }
        for (int e = blockIdx.x * 512 + tid; e < SEQ * 8; e += G * 512) {
            { const int t = e >> 3, i = e & 7; const float ang = (float)t * p.invp[i]; cosp[e] = cosf(ang); sinp[e] = sinf(ang); }
            if (e < 256 * 16) { const int t = e >> 4, i = e & 15; const float ang = (float)t * p.inva[i]; cosa[e] = cosf(ang); sina[e] = sinf(ang); }
        }
        for (int m = gw; m < BATCH * NMEM; m += NGW) row_pass(nullptr, nullptr, p.mem + (size_t)m * DM, nullptr, nullptr, nullptr, MEMN + (size_t)m * DM, p.mem_g, lane);
        for (int m = gw; m < MTOK; m += NGW) row_pass(nullptr, nullptr, p.x + (size_t)m * DM, HB + (size_t)m * DM, RS + m, nullptr, nullptr, nullptr, lane);
    }
    PH_END;

    for (int l = 0; l < DEPTH; ++l) {
        const int kind = l % 3;
        unsigned char* wl = ws + WS_W + (size_t)l * W_LAYER;
        if (PH_ON) { LAUNDER;
            if (l == 0) { pg8::Gemm g{MEMN, WKV, BATCH * NMEM, DEPTH * 512, DM}; pg8::StaticOrder S; S.init(BATCH * NMEM, DEPTH * 512, G, (int)blockIdx.x);
                EpiPlain E{KVM, DEPTH * 512}; pg8::gemm_phase<EpiPlain, pg8::StaticOrder, false, true>(lds, g, S, E, tl_); }
            pg8::Gemm g{HB, (const bf16_t*)(wl + WO_IN), MTOK, INWP, DM}; pg8::StaticOrder S; S.init(MTOK, INWP, G, (int)blockIdx.x);
            EpiIn E{Qb, Kb, Vb, QMb, kind, cosp, sinp, cosa, sina, p.qk_g + (l / 3) * 128, RS};
            pg8::gemm_phase<EpiIn, pg8::StaticOrder, true, true>(lds, g, S, E, tl_);
        }
        PH_END;
        if (PH_ON) { LAUNDER;
            const int r32 = lane & 31;
            for (int rep = 0; rep < (l == PROBE_ATT_L ? 2 : 1); ++rep) {
            if (rep) xcd_barrier(bar);
            for (int u = blockIdx.x; u < 2048; u += G) {
                if (u < 1536 && kind == 1) {
                    const int b = u / 768, rem = u % 768, kvh = rem >> 8, qb = rem & 255, head = 4 * kvh + (wid & 3); const long row = (long)b * SEQ + 64 * qb + 32 * (wid >> 2);
                    attn_body::attn_unit<8, QW, KVW, DM>(Qb + row * QW + head * 64, Kb + (long)b * SEQ * KVW + kvh * 64, Vb + (long)b * SEQ * KVW + kvh * 64, CTX + row * DM + head * 64, 256, (char*)lds_raw, tl_);
                    continue;
                }
                if (false) {
                    const int v = u - 1536, b = v >> 8, h = (v >> 6) & 3, qb = v & 63; const long row = (long)b * SEQ + 256 * qb + 32 * wid;
                    const bf16_t* kp = KVM + (long)b * NMEM * (DEPTH * 512) + l * 512 + h * 64;
                    attn_body::attn_unit<8, QMW, DEPTH * 512, DM>(QMb + row * QMW + h * 64, kp, kp + 256, CTX + row * DM + QW + h * 64, 4, (char*)lds_raw, tl_);
                    continue;
                }
                const bf16_t *Qp, *Kp, *Vp; bf16_t* Op; float* lsep = nullptr; int qpitch, kpitch, stride = 1, iq, tl, th, R = 1 << 30, q0 = 0; long qrb, krb; float sk = 0.f; bool hs = false;
                if (u < 1536) {
                    const int b = u / 768, rem = u % 768, kvh = rem >> 8, w = rem & 255, j = wid & 3, half = wid >> 2, head = 4 * kvh + j;
                    Qp = Qb + head * 64; qpitch = QW; Kp = Kb + kvh * 64; Vp = Vb + kvh * 64; kpitch = KVW; Op = CTX + head * 64;
                    int qb = w; qrb = (long)b * SEQ; tl = 0; th = 256;
                    if (kind == 2) { const int dil = 1 << (2 * kvh), nblk = 256 / dil, res = w / nblk; qb = w % nblk; stride = dil; qrb += res;
                        tl = qb - 1 < 0 ? 0 : qb - 1; th = qb + 2 > nblk ? nblk : qb + 2; R = 64; lsep = LSE + head; }
                    else if (kind == 0) { tl = qb - 2 < 0 ? 0 : qb - 2; th = qb + 3 > 256 ? 256 : qb + 3; R = 128; sk = p.sink[(l / 3) * NQH + head] * 1.4426950408889634f; hs = true; }
                    krb = qrb; q0 = 64 * qb; iq = q0 + 32 * half + r32;
                } else {
                    const int v = u - 1536, b = v >> 8, h = (v >> 6) & 3, qb = v & 63;
                    Qp = QMb + h * 64; qpitch = QMW; Kp = KVM + l * 512 + h * 64; Vp = Kp + 256; kpitch = DEPTH * 512; Op = CTX + QW + h * 64;
                    qrb = (long)b * SEQ; krb = (long)b * NMEM; tl = 0; th = 4; iq = 256 * qb + 32 * wid + r32;
                }
                attn_unit(lds, Qp, qpitch, qrb, stride, iq, Kp, Vp, kpitch, krb, stride, tl, th, R, q0, Op, DM, lsep, sk, hs, tl_);
            }
            }
        }
        PH_END;
        if (kind == 2) {
            if (PH_ON) { LAUNDER;
                for (int m = gw; m < MTOK; m += NGW) { const float* L = LSE + (size_t)m * 12; bf16_t* rowp = CTX + (size_t)m * DM;
#pragma unroll
                    for (int cc = 0; cc < 2; ++cc) { const int c = lane + 64 * cc; if (c < 96) { const float wgt = lse_weight(L, c >> 3);
                        u32x4 v = *(u32x4*)(rowp + c * 8);
                        v.x = pk2(bflo(v.x) * wgt, bfhi(v.x) * wgt); v.y = pk2(bflo(v.y) * wgt, bfhi(v.y) * wgt); v.z = pk2(bflo(v.z) * wgt, bfhi(v.z) * wgt); v.w = pk2(bflo(v.w) * wgt, bfhi(v.w) * wgt);
                        *(u32x4*)(rowp + c * 8) = v; } } }
            }
            PH_END;
        }
        if (PH_ON) { LAUNDER; pg8::Gemm g{CTX, (const bf16_t*)(wl + WO_O), MTOK, DM, DM}; pg8::StaticOrder S; S.init(MTOK, DM, G, (int)blockIdx.x);
            EpiPlain E{OB, DM}; pg8::gemm_phase<EpiPlain, pg8::StaticOrder, true, true>(lds, g, S, E, tl_); }
        PH_END;
        if (PH_ON) { LAUNDER;
            for (int m = gw; m < MTOK; m += NGW) row_pass(OB + (size_t)m * DM, p.g_mix_post + l * DM, nullptr, HB + (size_t)m * DM, RS + m, nullptr, nullptr, nullptr, lane); }
        PH_END;
        if (PH_ON) { LAUNDER; pg8::Gemm g{HB, (const bf16_t*)(wl + WO_GU), MTOK, GUW, DM}; pg8::StaticOrder S; S.init(MTOK, GUW, G, (int)blockIdx.x);
            EpiSwiGLU E{ACT, DFF, RS}; pg8::gemm_phase<EpiSwiGLU, pg8::StaticOrder, true, true>(lds, g, S, E, tl_); }
        PH_END;
        if (PH_ON) { LAUNDER; pg8::Gemm g{ACT, (const bf16_t*)(wl + WO_D), MTOK, DM, DFF}; pg8::StaticOrder S; S.init(MTOK, DM, G, (int)blockIdx.x);
            EpiPlain E{OB, DM}; pg8::gemm_phase<EpiPlain, pg8::StaticOrder, true, true>(lds, g, S, E, tl_); }
        PH_END;
        if (PH_ON) { LAUNDER; for (int m = gw; m < MTOK; m += NGW) row_pass(OB + (size_t)m * DM, p.g_ffn_post + l * DM, nullptr, HB + (size_t)m * DM, RS + m, l + 1 < DEPTH ? nullptr : p.out + (size_t)m * DM, nullptr, nullptr, lane); }
        PH_END;
    }
#undef PH_ON
#undef PH_END
}

extern "C" void kernel_launch(void* const* d_in, const int* in_sizes, int n_in, void* d_out, int out_size, void* d_ws, size_t ws_size, hipStream_t stream) {
    static int grid = 0;
    if (grid == 0) {
        if (n_in != 14 || in_sizes[0] != MTOK * DM || out_size != MTOK * DM || ws_size < WS_END) { fprintf(stderr, "kernel_launch: unexpected shapes (n_in %d, in0 %d, out %d, ws %zu)\n", n_in, n_in > 0 ? in_sizes[0] : -1, out_size, ws_size); grid = -1; return; }
        int dev = 0, cus = 0, per_cu = 0;
        hipGetDevice(&dev); hipDeviceGetAttribute(&cus, hipDeviceAttributeMultiprocessorCount, dev);
        if (hipFuncSetAttribute((const void*)fwd_megakernel, hipFuncAttributeMaxDynamicSharedMemorySize, LDS_BYTES) != hipSuccess) { fprintf(stderr, "kernel_launch: hipFuncSetAttribute failed\n"); grid = -1; return; }
        hipOccupancyMaxActiveBlocksPerMultiprocessor(&per_cu, (const void*)fwd_megakernel, 512, LDS_BYTES);
        (void)hipGetLastError();
        if (per_cu < 1) fprintf(stderr, "kernel_launch: occupancy query says %d blocks/CU\n", per_cu);
        grid = cus;
    }
    if (grid < 0) return;
    if (hipMemsetAsync((char*)d_ws + WS_CTL, 0, CTL_BYTES, stream) != hipSuccess) { fprintf(stderr, "kernel_launch: memset failed\n"); return; }
    Params p{};
    p.x = (const float*)d_in[0]; p.mem = (const float*)d_in[1]; p.mem_g = (const float*)d_in[2]; p.w_in = (const float*)d_in[3]; p.w_kv = (const float*)d_in[4]; p.w_o = (const float*)d_in[5];
    p.g_mix_pre = (const float*)d_in[6]; p.g_mix_post = (const float*)d_in[7]; p.sink = (const float*)d_in[8]; p.qk_g = (const float*)d_in[9];
    p.w_gu = (const float*)d_in[10]; p.w_d = (const float*)d_in[11]; p.g_ffn_pre = (const float*)d_in[12]; p.g_ffn_post = (const float*)d_in[13];
    p.out = (float*)d_out; p.ws = (unsigned char*)d_ws;
    for (int i = 0; i < 8; ++i) p.invp[i] = powf(500000.0f, -((float)(2 * i) / 16.0f));
    for (int i = 0; i < 16; ++i) p.inva[i] = powf(10000.0f, -((float)(2 * i) / 32.0f));
    p.ph_lo = 0; p.ph_hi = NPHASES;
    void* args[] = {&p};
    hipError_t e = hipLaunchCooperativeKernel((const void*)fwd_megakernel, dim3(grid), dim3(512), args, LDS_BYTES, stream);
    if (e != hipSuccess) fprintf(stderr, "cooperative launch failed: %s (grid %d)\n", hipGetErrorString(e), grid);
}
```
